# Optimizing an MI355X kernel written in HIP

```python
import math
import jax, jax.numpy as jnp
from jax import lax
import numpy as np

D_MODEL = 1024
BATCH = 32
SEQ = 256
DEPTH = 2
DEC_BATCH = 2
DEC_SEQ = 4096
PAST_LEN = 512

GRID_W = 64
D_MIX = D_MODEL
GROUP_W = D_MIX // 4
RWKV_HEADS = 4
RWKV_HD = GROUP_W // RWKV_HEADS
RWKV_LORA_W = 32
RWKV_LORA_A = 32
RWKV_LORA_G = 64
RWKV_GN_EPS = 64e-5
RWKV_PROJ = 3 * GROUP_W + 2 * RWKV_LORA_W + 2 * RWKV_LORA_A + RWKV_LORA_G
RET_HEADS = 4
RET_HD = GROUP_W // RET_HEADS
RET_DECAY_FWD = 5.0
RET_DECAY_BWD = 5.5
RET_PROJ = 4 * GROUP_W
SSD_HEADS = 4
SSD_HD = GROUP_W // SSD_HEADS
SSD_STATE = 64
SSD_GROUPS = 2
SSD_CONV = 3
SSD_CONV_DIM = GROUP_W + 2 * SSD_GROUPS * SSD_STATE
SSD_PROJ = GROUP_W + SSD_CONV_DIM + 2 * SSD_HEADS
DIFF_HEADS = 4
DIFF_VD = GROUP_W // DIFF_HEADS
DIFF_QK = DIFF_VD // 2
DIFF_PROJ = 3 * GROUP_W
P_IN = RWKV_PROJ + RET_PROJ + SSD_PROJ + DIFF_PROJ
FFN_DIM = 2816
FFN_CONV = 3
CHUNK = 128
Q_BLOCK = 128
ROPE_BASE = 10000.0
EPS = 1e-6

kernel_name = 'hybrid_diffusion_prefix_trunk_step'


def rmsnorm(x, g):
    xf = x.astype(jnp.float32)
    y = xf * lax.rsqrt(jnp.mean(xf * xf, axis=-1, keepdims=True) + EPS)
    return y.astype(x.dtype) * g


def head_rmsnorm(y):
    yf = y.astype(jnp.float32)
    return (yf * lax.rsqrt(jnp.mean(yf * yf, axis=-1, keepdims=True) + EPS)).astype(y.dtype)


def group_norm_heads(y, g, b, eps):
    yf = y.astype(jnp.float32)
    mu = jnp.mean(yf, axis=-1, keepdims=True)
    var = jnp.mean(jnp.square(yf - mu), axis=-1, keepdims=True)
    yn = ((yf - mu) * lax.rsqrt(var + eps)).astype(y.dtype)
    return yn.reshape(y.shape[0], y.shape[1], -1) * g + b


def centred_neighbour_avg(x):
    xp = jnp.pad(x, ((0, 0), (1, 1), (0, 0)))
    return 0.5 * (xp[:, :-2] + xp[:, 2:])


def depthwise_conv_centred(x, w, b):
    k = w.shape[0]
    half = k // 2
    t = x.shape[1]
    xp = jnp.pad(x, ((0, 0), (half, half), (0, 0)))
    out = b
    for i in range(k):
        out = out + xp[:, i:i + t] * w[i]
    return out


def flip_t(a):
    return a[:, ::-1]


def axial_rope_tables(rows, d):
    nf = d // 4
    row = jnp.repeat(jnp.arange(rows, dtype=jnp.float32), GRID_W)
    col = jnp.tile(jnp.arange(GRID_W, dtype=jnp.float32), rows)
    freqs = ROPE_BASE ** (-jnp.arange(nf, dtype=jnp.float32) / nf)
    ang = jnp.concatenate([row[:, None] * freqs, col[:, None] * freqs], axis=-1)
    return jnp.cos(ang), jnp.sin(ang)


def apply_rope(x, rope):
    if rope is None:
        return x
    cos, sin = rope
    d2 = cos.shape[-1]
    shape = (1, cos.shape[0]) + (1,) * (x.ndim - 3) + (d2,)
    c = cos.reshape(shape).astype(x.dtype)
    s = sin.reshape(shape).astype(x.dtype)
    x1, x2 = x[..., :d2], x[..., d2:]
    return jnp.concatenate([x1 * c - x2 * s, x2 * c + x1 * s], axis=-1)


def chunked_decay_scan(q, k, v, logdecay, s0):
    b, t, h, dk = q.shape
    dv = v.shape[-1]
    n = t // CHUNK

    def to_chunks(a):
        return jnp.moveaxis(a.reshape((b, n, CHUNK) + a.shape[2:]), 1, 0)

    causal = jnp.tril(jnp.ones((CHUNK, CHUNK), dtype=bool))[None, :, :, None]

    def step(s, inp):
        qc, kc, vc, gc = inp
        cum = jnp.cumsum(gc.astype(jnp.float32), axis=1)
        rel = cum[:, :, None, :] - cum[:, None, :, :]
        decay = jnp.where(causal, jnp.exp(jnp.where(causal, rel, 0.0)), 0.0).astype(qc.dtype)
        scores = jnp.einsum('bihd,bjhd->bijh', qc, kc) * decay
        y = jnp.einsum('bijh,bjhe->bihe', scores, vc)
        y = y + jnp.einsum('bihd,bhde->bihe', qc * jnp.exp(cum).astype(qc.dtype)[..., None], s)
        last = cum[:, -1]
        kw = kc * jnp.exp(last[:, None, :] - cum).astype(kc.dtype)[..., None]
        s_new = s * jnp.exp(last).astype(s.dtype)[:, :, None, None] + jnp.einsum('bjhd,bjhe->bhde', kw, vc)
        return s_new.astype(s.dtype), y

    s_fin, ys = lax.scan(step, s0, (to_chunks(q), to_chunks(k), to_chunks(v), to_chunks(logdecay)))
    return jnp.moveaxis(ys, 0, 1).reshape(b, t, h, dv), s_fin


def rwkv_scan(r, w, k, v, kk, a, s0):
    def step(s, inp):
        r_t, w_t, k_t, v_t, kk_t, a_t = inp
        sa = jnp.einsum('bhvk,bhk->bhv', s, -kk_t)
        s = s * w_t[:, :, None, :] + sa[..., None] * (kk_t * a_t)[:, :, None, :] + v_t[..., None] * k_t[:, :, None, :]
        return s, jnp.einsum('bhvk,bhk->bhv', s, r_t)

    xs = tuple(jnp.moveaxis(a_, 1, 0) for a_ in (r, w, k, v, kk, a))
    s_fin, ys = lax.scan(step, s0, xs)
    return jnp.moveaxis(ys, 0, 1), s_fin


def rwkv_mixer(f, p, s0):
    b, t, _ = f.shape
    f = f + p['rwkv_mu'] * (centred_neighbour_avg(f) - f)
    o1 = 3 * GROUP_W
    r, k, v, wd, ad, gd = jnp.split(
        f, [GROUP_W, 2 * GROUP_W, o1, o1 + 2 * RWKV_LORA_W, o1 + 2 * RWKV_LORA_W + 2 * RWKV_LORA_A], axis=-1)

    def hs(a_):
        return a_.reshape(b, t, RWKV_HEADS, RWKV_HD)

    wd = wd.reshape(b, t, 2, RWKV_LORA_W)
    ad = ad.reshape(b, t, 2, RWKV_LORA_A)
    w_lora = jnp.einsum('btdr,drc->btdc', jnp.tanh(wd), p['rwkv_w_up'])
    decay = jnp.exp(-jnp.exp(-jax.nn.softplus(-(p['rwkv_w0'] + w_lora)) - 0.5))
    a = jax.nn.sigmoid(p['rwkv_a0'] + jnp.einsum('btdr,drc->btdc', ad, p['rwkv_a_up']))
    g = jax.nn.sigmoid(gd) @ p['rwkv_g_up']
    kkf = hs(k * p['rwkv_k_k']).astype(jnp.float32)
    kk = (kkf * lax.rsqrt(jnp.maximum(jnp.sum(kkf * kkf, axis=-1, keepdims=True), 1e-12))).astype(k.dtype)
    rh, vh = hs(r), hs(v)
    a_f, a_b = a[:, :, 0], a[:, :, 1]
    k_f = hs(k * (1.0 + (a_f - 1.0) * p['rwkv_k_a']))
    k_b = hs(k * (1.0 + (a_b - 1.0) * p['rwkv_k_a']))
    y_f, s_f = rwkv_scan(rh, hs(decay[:, :, 0]), k_f, vh, kk, hs(a_f), s0[:, 0])
    y_b, s_b = rwkv_scan(flip_t(rh), flip_t(hs(decay[:, :, 1])), flip_t(k_b), flip_t(vh), flip_t(kk),
                         flip_t(hs(a_b)), s0[:, 1])
    y = group_norm_heads(y_f + flip_t(y_b), p['rwkv_ln_g'], p['rwkv_ln_b'], RWKV_GN_EPS)
    bonus = (jnp.sum(rh * hs(k) * p['rwkv_r_k'], axis=-1, keepdims=True) * vh).reshape(b, t, GROUP_W)
    return (y + bonus) * g, jnp.stack([s_f, s_b], axis=1)


def retention_mixer(f, p, rope, s0):
    b, t, _ = f.shape
    q, k, v, g = jnp.split(f, 4, axis=-1)

    def hs(a_):
        return a_.reshape(b, t, RET_HEADS, RET_HD)

    q = apply_rope(hs(q), rope)
    k = apply_rope(hs(k), rope) * (RET_HD ** -0.5)
    v = hs(v)
    heads = jnp.arange(RET_HEADS, dtype=jnp.float32)
    log_g_f = jnp.broadcast_to(jnp.log(1.0 - 2.0 ** (-RET_DECAY_FWD - heads)), (b, t, RET_HEADS))
    log_g_b = jnp.broadcast_to(jnp.log(1.0 - 2.0 ** (-RET_DECAY_BWD - heads)), (b, t, RET_HEADS))
    y_f, s_f = chunked_decay_scan(q, k, v, log_g_f, s0[:, 0])
    y_b, s_b = chunked_decay_scan(flip_t(q), flip_t(k), flip_t(v), log_g_b, s0[:, 1])
    y = head_rmsnorm(y_f + flip_t(y_b)).reshape(b, t, GROUP_W) * p['ret_ln_g']
    return jax.nn.silu(g) * y, jnp.stack([s_f, s_b], axis=1)


def ssd_mixer(f, p, s0):
    b, t, _ = f.shape
    z, xbc, dt = jnp.split(f, [GROUP_W, GROUP_W + SSD_CONV_DIM], axis=-1)
    xbc = jax.nn.silu(depthwise_conv_centred(xbc, p['ssd_conv_w'], p['ssd_conv_b']))
    x, bm, cm = jnp.split(xbc, [GROUP_W, GROUP_W + SSD_GROUPS * SSD_STATE], axis=-1)
    x = x.reshape(b, t, SSD_HEADS, SSD_HD)
    rep = SSD_HEADS // SSD_GROUPS
    bm = jnp.repeat(bm.reshape(b, t, SSD_GROUPS, SSD_STATE), rep, axis=2)
    cm = jnp.repeat(cm.reshape(b, t, SSD_GROUPS, SSD_STATE), rep, axis=2)
    dt = jax.nn.softplus(dt.reshape(b, t, 2, SSD_HEADS) + p['ssd_dt_bias'])
    a = -jnp.exp(p['ssd_a_log'])
    y_f, s_f = chunked_decay_scan(cm, bm, x * dt[:, :, 0, :, None], a[0] * dt[:, :, 0], s0[:, 0])
    y_b, s_b = chunked_decay_scan(flip_t(cm), flip_t(bm), flip_t(x * dt[:, :, 1, :, None]),
                                  flip_t(a[1] * dt[:, :, 1]), s0[:, 1])
    y = y_f + flip_t(y_b) + x * p['ssd_d'][:, None]
    y = rmsnorm(y.reshape(b, t, GROUP_W) * jax.nn.silu(z), p['ssd_norm_g'])
    return y, jnp.stack([s_f, s_b], axis=1)


def diff_attention(q, k, v, lam):
    b, t, h, _, dq = q.shape
    nb = t // Q_BLOCK
    qb = jnp.moveaxis(q.reshape(b, nb, Q_BLOCK, h, 2, dq), 1, 0)
    scale = dq ** -0.5

    def block(qi):
        s = jnp.einsum('bqhmd,bshmd->bhmqs', qi, k).astype(jnp.float32) * scale
        pr = jax.nn.softmax(s, axis=-1)
        attn = pr[:, :, 0] - lam * pr[:, :, 1]
        return jnp.einsum('bhqs,bshe->bqhe', attn.astype(v.dtype), v)

    o = lax.map(block, qb)
    return jnp.moveaxis(o, 0, 1).reshape(b, t, h, v.shape[-1])


def diff_mixer(f, p, lam_init, rope, ctx_k, ctx_v):
    b, t, _ = f.shape
    q, k, v = jnp.split(f, 3, axis=-1)
    q = q.reshape(b, t, DIFF_HEADS, 2, DIFF_QK)
    k = k.reshape(b, t, DIFF_HEADS, 2, DIFF_QK)
    v = v.reshape(b, t, DIFF_HEADS, DIFF_VD)
    lp = p['diff_lambda'].astype(jnp.float32)
    lam = jnp.exp(jnp.sum(lp[0] * lp[1])) - jnp.exp(jnp.sum(lp[2] * lp[3])) + lam_init
    qr = apply_rope(q, rope)
    kr = apply_rope(k, rope)
    if ctx_k is None:
        keys, vals = kr, v
    else:
        keys = jnp.concatenate([kr, ctx_k], axis=1)
        vals = jnp.concatenate([v, ctx_v], axis=1)
    o = diff_attention(qr, keys, vals, lam)
    o = head_rmsnorm(o) * p['diff_subln_g'] * (1.0 - lam_init)
    return o.reshape(b, t, GROUP_W), k, v


def conv_ffn(h, p):
    u = depthwise_conv_centred(h @ p['ffn_w_up'], p['ffn_conv_w'], p['ffn_conv_b'])
    gate, val = jnp.split(u, 2, axis=-1)
    return (jax.nn.silu(gate) * val) @ p['ffn_w_down']


def trunk_layer(x, mod, p, lam_init, rope_ret, rope_diff, s_rwkv, s_ret, s_ssd, ctx_k, ctx_v):
    shift1, scale1, gate1, shift2, scale2, gate2 = jnp.split(mod, 6, axis=-1)
    h = rmsnorm(x, p['norm1_g']) * (1.0 + scale1) + shift1
    f = h @ p['w_in']
    fa, fb, fc, fd = jnp.split(f, [RWKV_PROJ, RWKV_PROJ + RET_PROJ, RWKV_PROJ + RET_PROJ + SSD_PROJ], axis=-1)
    oa, sa = rwkv_mixer(fa, p, s_rwkv)
    ob, sb = retention_mixer(fb, p, rope_ret, s_ret)
    oc, sc = ssd_mixer(fc, p, s_ssd)
    od, kd, vd = diff_mixer(fd, p, lam_init, rope_diff, ctx_k, ctx_v)
    x = x + gate1 * (jnp.concatenate([oa, ob, oc, od], axis=-1) @ p['w_out'])
    h = rmsnorm(x, p['norm2_g']) * (1.0 + scale2) + shift2
    x = x + gate2 * conv_ffn(h, p)
    return x, sa, sb, sc, kd, vd


def setup_inputs(seed: int = 0) -> dict:
    key = jax.random.key(seed)
    ks = iter(jax.random.split(key, 64))
    f32 = jnp.float32

    def nrm(shape, scale):
        return jax.random.normal(next(ks), shape, f32) * scale

    def unif(shape, lo, hi):
        return jax.random.uniform(next(ks), shape, f32, lo, hi)

    x_prompt = nrm((BATCH, SEQ, D_MODEL), 1.0)
    x_sample = nrm((DEC_BATCH, DEC_SEQ, D_MODEL), 1.0)
    state_rwkv = nrm((DEC_BATCH, DEPTH, 2, RWKV_HEADS, RWKV_HD, RWKV_HD), 0.3)
    state_ret = nrm((DEC_BATCH, DEPTH, 2, RET_HEADS, RET_HD, RET_HD), 0.3)
    state_ssd = nrm((DEC_BATCH, DEPTH, 2, SSD_HEADS, SSD_STATE, SSD_HD), 0.3)
    cache_diff_k = nrm((DEC_BATCH, DEPTH, PAST_LEN, DIFF_HEADS, 2, DIFF_QK), 1.0)
    cache_diff_v = nrm((DEC_BATCH, DEPTH, PAST_LEN, DIFF_HEADS, DIFF_VD), 1.0)
    c = nrm((DEC_BATCH, D_MODEL), 1.0)
    c_ctx = nrm((D_MODEL,), 1.0)
    norm1_g = 1.0 + nrm((DEPTH, D_MODEL), 0.02)
    norm2_g = 1.0 + nrm((DEPTH, D_MODEL), 0.02)
    w_mod = nrm((DEPTH, D_MODEL, 6 * D_MODEL), 0.5 * D_MODEL ** -0.5)
    b_mod = nrm((DEPTH, 6 * D_MODEL), 0.02)
    w_in = nrm((DEPTH, D_MODEL, P_IN), D_MODEL ** -0.5)
    w_out = nrm((DEPTH, D_MIX, D_MODEL), D_MIX ** -0.5)
    rwkv_mu = unif((DEPTH, RWKV_PROJ), 0.2, 0.8)
    rwkv_w0 = nrm((DEPTH, 2, GROUP_W), 0.5)
    rwkv_w_up = nrm((DEPTH, 2, RWKV_LORA_W, GROUP_W), 0.1)
    rwkv_a0 = nrm((DEPTH, 2, GROUP_W), 0.1)
    rwkv_a_up = nrm((DEPTH, 2, RWKV_LORA_A, GROUP_W), 0.1)
    rwkv_g_up = nrm((DEPTH, RWKV_LORA_G, GROUP_W), RWKV_LORA_G ** -0.5)
    rwkv_k_k = 0.85 + nrm((DEPTH, GROUP_W), 0.02)
    rwkv_k_a = 1.0 + nrm((DEPTH, GROUP_W), 0.02)
    rwkv_r_k = nrm((DEPTH, RWKV_HEADS, RWKV_HD), 0.1)
    rwkv_ln_g = 1.0 + nrm((DEPTH, GROUP_W), 0.02)
    rwkv_ln_b = nrm((DEPTH, GROUP_W), 0.02)
    ret_ln_g = 1.0 + nrm((DEPTH, GROUP_W), 0.02)
    ssd_conv_w = nrm((DEPTH, SSD_CONV, SSD_CONV_DIM), SSD_CONV ** -0.5)
    ssd_conv_b = nrm((DEPTH, SSD_CONV_DIM), 0.02)
    dt0 = jnp.exp(unif((DEPTH, 2, SSD_HEADS), math.log(1e-3), math.log(1e-1)))
    ssd_dt_bias = dt0 + jnp.log(-jnp.expm1(-dt0))
    ssd_a_log = jnp.log(unif((DEPTH, 2, SSD_HEADS), 1.0, 16.0))
    ssd_d = 1.0 + nrm((DEPTH, SSD_HEADS), 0.02)
    ssd_norm_g = 1.0 + nrm((DEPTH, GROUP_W), 0.02)
    diff_lambda = nrm((DEPTH, 4, DIFF_QK), 0.1)
    diff_subln_g = 1.0 + nrm((DEPTH, DIFF_VD), 0.02)
    ffn_w_up = nrm((DEPTH, D_MODEL, 2 * FFN_DIM), D_MODEL ** -0.5)
    ffn_conv_w = nrm((DEPTH, FFN_CONV, 2 * FFN_DIM), FFN_CONV ** -0.5)
    ffn_conv_b = nrm((DEPTH, 2 * FFN_DIM), 0.02)
    ffn_w_down = nrm((DEPTH, FFN_DIM, D_MODEL), FFN_DIM ** -0.5)
    norm_f_g = 1.0 + nrm((D_MODEL,), 0.02)
    return {'x_prompt': x_prompt, 'x_sample': x_sample, 'state_rwkv': state_rwkv, 'state_ret': state_ret,
            'state_ssd': state_ssd, 'cache_diff_k': cache_diff_k, 'cache_diff_v': cache_diff_v,
            'c': c, 'c_ctx': c_ctx, 'norm1_g': norm1_g, 'norm2_g': norm2_g, 'w_mod': w_mod, 'b_mod': b_mod,
            'w_in': w_in, 'w_out': w_out, 'rwkv_mu': rwkv_mu, 'rwkv_w0': rwkv_w0, 'rwkv_w_up': rwkv_w_up,
            'rwkv_a0': rwkv_a0, 'rwkv_a_up': rwkv_a_up, 'rwkv_g_up': rwkv_g_up, 'rwkv_k_k': rwkv_k_k,
            'rwkv_k_a': rwkv_k_a, 'rwkv_r_k': rwkv_r_k, 'rwkv_ln_g': rwkv_ln_g, 'rwkv_ln_b': rwkv_ln_b,
            'ret_ln_g': ret_ln_g, 'ssd_conv_w': ssd_conv_w, 'ssd_conv_b': ssd_conv_b, 'ssd_dt_bias': ssd_dt_bias,
            'ssd_a_log': ssd_a_log, 'ssd_d': ssd_d, 'ssd_norm_g': ssd_norm_g, 'diff_lambda': diff_lambda,
            'diff_subln_g': diff_subln_g, 'ffn_w_up': ffn_w_up, 'ffn_conv_w': ffn_conv_w, 'ffn_conv_b': ffn_conv_b,
            'ffn_w_down': ffn_w_down, 'norm_f_g': norm_f_g}


def reference(x_prompt, x_sample, state_rwkv, state_ret, state_ssd, cache_diff_k, cache_diff_v, c, c_ctx,
              norm1_g, norm2_g, w_mod, b_mod, w_in, w_out, rwkv_mu, rwkv_w0, rwkv_w_up, rwkv_a0, rwkv_a_up,
              rwkv_g_up, rwkv_k_k, rwkv_k_a, rwkv_r_k, rwkv_ln_g, rwkv_ln_b, ret_ln_g, ssd_conv_w, ssd_conv_b,
              ssd_dt_bias, ssd_a_log, ssd_d, ssd_norm_g, diff_lambda, diff_subln_g, ffn_w_up, ffn_conv_w,
              ffn_conv_b, ffn_w_down, norm_f_g):
    rows = x_sample.shape[1] // GRID_W
    rope_ret = axial_rope_tables(rows, RET_HD)
    rope_diff = axial_rope_tables(rows, DIFF_QK)
    bp = x_prompt.shape[0]
    dtp = x_prompt.dtype
    xp, xs = x_prompt, x_sample
    new_rwkv, new_ret, new_ssd, new_k, new_v = [], [], [], [], []
    for l in range(DEPTH):
        p = {'norm1_g': norm1_g[l], 'norm2_g': norm2_g[l], 'w_in': w_in[l], 'w_out': w_out[l],
             'rwkv_mu': rwkv_mu[l], 'rwkv_w0': rwkv_w0[l], 'rwkv_w_up': rwkv_w_up[l], 'rwkv_a0': rwkv_a0[l],
             'rwkv_a_up': rwkv_a_up[l], 'rwkv_g_up': rwkv_g_up[l], 'rwkv_k_k': rwkv_k_k[l],
             'rwkv_k_a': rwkv_k_a[l], 'rwkv_r_k': rwkv_r_k[l], 'rwkv_ln_g': rwkv_ln_g[l],
             'rwkv_ln_b': rwkv_ln_b[l], 'ret_ln_g': ret_ln_g[l], 'ssd_conv_w': ssd_conv_w[l],
             'ssd_conv_b': ssd_conv_b[l], 'ssd_dt_bias': ssd_dt_bias[l], 'ssd_a_log': ssd_a_log[l],
             'ssd_d': ssd_d[l], 'ssd_norm_g': ssd_norm_g[l], 'diff_lambda': diff_lambda[l],
             'diff_subln_g': diff_subln_g[l], 'ffn_w_up': ffn_w_up[l], 'ffn_conv_w': ffn_conv_w[l],
             'ffn_conv_b': ffn_conv_b[l], 'ffn_w_down': ffn_w_down[l]}
        lam_init = 0.8 - 0.6 * math.exp(-0.3 * l)
        mod_ctx = (jax.nn.silu(c_ctx) @ w_mod[l] + b_mod[l])[None, None, :]
        mod_lat = (jax.nn.silu(c) @ w_mod[l] + b_mod[l])[:, None, :]
        xp, sa, sb, sc, kd, vd = trunk_layer(
            xp, mod_ctx, p, lam_init, None, None,
            jnp.zeros((bp, 2, RWKV_HEADS, RWKV_HD, RWKV_HD), dtp),
            jnp.zeros((bp, 2, RET_HEADS, RET_HD, RET_HD), dtp),
            jnp.zeros((bp, 2, SSD_HEADS, SSD_STATE, SSD_HD), dtp), None, None)
        new_rwkv.append(sa)
        new_ret.append(sb)
        new_ssd.append(sc)
        new_k.append(kd)
        new_v.append(vd)
        xs, _, _, _, _, _ = trunk_layer(
            xs, mod_lat, p, lam_init, rope_ret, rope_diff, state_rwkv[:, l], state_ret[:, l],
            state_ssd[:, l], cache_diff_k[:, l], cache_diff_v[:, l])
    y_prompt = rmsnorm(xp, norm_f_g)
    y_sample = rmsnorm(xs, norm_f_g)
    new_state_rwkv = jnp.stack(new_rwkv, axis=1)
    new_state_ret = jnp.stack(new_ret, axis=1)
    new_state_ssd = jnp.stack(new_ssd, axis=1)
    new_cache_diff_k = jnp.stack(new_k, axis=1)
    new_cache_diff_v = jnp.stack(new_v, axis=1)
    return (y_prompt, y_sample, new_state_rwkv, new_state_ret, new_state_ssd, new_cache_diff_k, new_cache_diff_v)
```

```cpp
#include <hip/hip_runtime.h>
#include <hip/hip_cooperative_groups.h>
#include <cstdio>
namespace cg = cooperative_groups;

#ifndef COOP
#define COOP 1
#endif
#ifndef PROBE_MASK
#define PROBE_MASK 0
#endif

#define DI __device__ __forceinline__
typedef unsigned short bf16_t;
typedef _Float16 h16;
using bf16x8 = __attribute__((ext_vector_type(8))) short;
using h16x8 = __attribute__((ext_vector_type(8))) _Float16;
using f32x16 = __attribute__((ext_vector_type(16))) float;
typedef float v4f_t __attribute__((ext_vector_type(4)));
typedef float v2f_t __attribute__((ext_vector_type(2)));
#define MFMA32(a, b, c) __builtin_amdgcn_mfma_f32_32x32x16_bf16((a), (b), (c), 0, 0, 0)

constexpr int D = 1024, PIN = 3528, PINP = 3584, FF = 2816, FF2 = 5632, NT = 8192;
constexpr int OA = 0, OB = 960, OC = 1984, OD = 2760;
constexpr int NPHASE = 38;

enum { I_XP = 0, I_XS, I_SRW, I_SRET, I_SSSD, I_CK, I_CV, I_C, I_CCTX, I_N1G, I_N2G, I_WMOD, I_BMOD, I_WIN, I_WOUT,
       I_MU, I_W0, I_WUP, I_A0, I_AUP, I_GUP, I_KK, I_KA, I_RK, I_LNG, I_LNB, I_RETG, I_SCW, I_SCB, I_DTB, I_ALOG,
       I_SD, I_SNG, I_DLAM, I_DSUB, I_FUP, I_FCW, I_FCB, I_FDN, I_NFG };

constexpr size_t O_YP = 0, O_YS = 8388608, O_SRW = 16777216, O_SRET = 18874368, O_SSSD = 20971520,
                 O_CK = 23068672, O_CV = 27262976;

constexpr size_t WS_WIN = 0;
constexpr size_t WS_WOUT = WS_WIN + (size_t)PINP * D * 2;
constexpr size_t WS_WUP = WS_WOUT + (size_t)D * D * 2;
constexpr size_t WS_WDN = WS_WUP + (size_t)FF2 * D * 2;
constexpr size_t WS_MOD = WS_WDN + (size_t)D * FF * 2;
constexpr size_t WS_ROPE_RET = WS_MOD + (size_t)2 * 3 * 6144 * 4;
constexpr size_t WS_ROPE_DIF = WS_ROPE_RET + (size_t)2 * 4096 * 32 * 4;
constexpr size_t WS_HBUF = WS_ROPE_DIF + (size_t)2 * 4096 * 16 * 4;
constexpr size_t WS_CAT = WS_HBUF + (size_t)NT * D * 2;
constexpr size_t WS_F = WS_CAT + (size_t)NT * D * 2;
constexpr size_t WS_FEED_RW = WS_F + (size_t)NT * PIN * 2;
constexpr size_t WS_FEED_RET = WS_FEED_RW + (size_t)NT * 2304 * 2;
constexpr size_t WS_FEED_SSD = WS_FEED_RET + (size_t)NT * 768 * 2;
constexpr size_t WS_DTG = WS_FEED_SSD + (size_t)NT * 512 * 2;
constexpr size_t WS_RG = WS_DTG + (size_t)NT * 16 * 4;
constexpr size_t WS_BONUS = WS_RG + (size_t)NT * 256 * 2;
constexpr size_t WS_Y = WS_BONUS + (size_t)NT * 256 * 2;
constexpr size_t WS_KR = WS_Y + (size_t)6 * NT * 256 * 4;
constexpr size_t WS_VT = WS_KR + (size_t)2 * 4 * 2 * 4608 * 32 * 2;
constexpr size_t WS_END = WS_VT + (size_t)2 * 4 * 64 * 4608 * 2;
constexpr size_t WS_QGZ = WS_END;
constexpr size_t WS_BAR = WS_QGZ + (size_t)NT * 768 * 2;
constexpr size_t WS_END2 = WS_BAR + 16384;
constexpr size_t WS_U = WS_FEED_RW;
constexpr size_t WS_ACT = WS_U + (size_t)NT * FF2 * 2;
static_assert(WS_ACT + (size_t)NT * FF * 2 <= WS_BAR, "ACT alias");
static_assert(WS_END2 <= (size_t)256 * 1024 * 1024, "ws");

constexpr int SMEM_BYTES = 49664;
constexpr int TC = 16;
constexpr int SST = 388;
constexpr int SBUF = TC * SST;

struct Params {
  const float* in[40];
  float* out;
  char* ws;
};

typedef float f32x2_t __attribute__((ext_vector_type(2)));
typedef __bf16 bf16x2_t __attribute__((ext_vector_type(2)));
DI unsigned pack2(float a, float b) {
  f32x2_t v;
  v.x = a;
  v.y = b;
  return __builtin_bit_cast(unsigned, __builtin_convertvector(v, bf16x2_t));
}
DI bf16_t f2bf(float x) { return (bf16_t)(pack2(x, 0.f) & 0xffffu); }
DI float bf2f(bf16_t b) { return __uint_as_float(((unsigned)b) << 16); }
DI float fexp(float x) { return __expf(x); }
DI float frcp(float x) { return __builtin_amdgcn_rcpf(x); }
DI float silu_f(float x) { return x * frcp(1.f + fexp(-x)); }
DI float sigmoid_f(float x) { return frcp(1.f + fexp(-x)); }
DI float softplus_f(float x) { return fmaxf(x, 0.f) + __logf(1.f + fexp(-fabsf(x))); }
DI float tanh_f(float x) { return 1.f - 2.f * frcp(fexp(2.f * x) + 1.f); }
DI float wave_sum(float v) {
#pragma unroll
  for (int o = 32; o > 0; o >>= 1) v += __shfl_xor(v, o);
  return v;
}
DI float dpp_ror(float v, int) { return v; }
DI float row_sum16(float v) {
  v += __builtin_bit_cast(float, __builtin_amdgcn_update_dpp(0, __builtin_bit_cast(int, v), 0x128, 0xf, 0xf, false));
  v += __builtin_bit_cast(float, __builtin_amdgcn_update_dpp(0, __builtin_bit_cast(int, v), 0x124, 0xf, 0xf, false));
  v += __builtin_bit_cast(float, __builtin_amdgcn_update_dpp(0, __builtin_bit_cast(int, v), 0x122, 0xf, 0xf, false));
  v += __builtin_bit_cast(float, __builtin_amdgcn_update_dpp(0, __builtin_bit_cast(int, v), 0x121, 0xf, 0xf, false));
  return v;
}
DI int tidx() {
  int t = (int)__builtin_amdgcn_workitem_id_x();
  asm volatile("" : "+v"(t));
  return t;
}
template <class T>
DI T* opaque(T* q) {
  asm volatile("" : "+s"(q));
  return q;
}
DI void lds_barrier() { asm volatile("s_waitcnt lgkmcnt(0)\n\ts_barrier" ::: "memory"); }
DI int crow(int i, int hf) { return (i & 3) + 8 * (i >> 2) + 4 * hf; }

DI const bf16_t* wsbf(const Params& p, size_t off) { return (const bf16_t*)(p.ws + off); }

DI void stage0(const Params& p, char* smem) {
  float* sil = (float*)smem;
  float* red = sil + 3072;
  const int tid = tidx(), lane = tid & 63, wv = tid >> 6;
  float* MOD = (float*)(p.ws + WS_MOD);
  for (int i = tid; i < 3072; i += 256) {
    int c = i >> 10, k = i & 1023;
    float v = (c == 0) ? p.in[I_CCTX][k] : p.in[I_C][(c - 1) * 1024 + k];
    sil[i] = silu_f(v);
  }
  __syncthreads();
  for (int task = blockIdx.x; task < 192; task += gridDim.x) {
    int l = task / 96, j0 = (task % 96) * 64;
    const float* wm = p.in[I_WMOD] + (size_t)l * 1024 * 6144 + j0 + lane;
    float a0 = 0.f, a1 = 0.f, a2 = 0.f;
    int kb = wv * 256;
#pragma unroll 8
    for (int k = 0; k < 256; ++k) {
      float w = wm[(size_t)(kb + k) * 6144];
      a0 += sil[kb + k] * w;
      a1 += sil[1024 + kb + k] * w;
      a2 += sil[2048 + kb + k] * w;
    }
    red[(wv * 3 + 0) * 64 + lane] = a0;
    red[(wv * 3 + 1) * 64 + lane] = a1;
    red[(wv * 3 + 2) * 64 + lane] = a2;
    __syncthreads();
    if (tid < 192) {
      int c = tid >> 6, j = tid & 63;
      float s = red[(0 * 3 + c) * 64 + j] + red[(1 * 3 + c) * 64 + j] + red[(2 * 3 + c) * 64 + j] + red[(3 * 3 + c) * 64 + j];
      MOD[(size_t)(l * 3 + c) * 6144 + j0 + j] = s + p.in[I_BMOD][l * 6144 + j0 + j];
    }
    __syncthreads();
  }
  float* rc = (float*)(p.ws + WS_ROPE_RET);
  float* rs = rc + 4096 * 32;
  float* dc = (float*)(p.ws + WS_ROPE_DIF);
  float* ds = dc + 4096 * 16;
  const int gt = blockIdx.x * 256 + tid, gs = gridDim.x * 256;
  for (int i = gt; i < 4096 * 32; i += gs) {
    int t = i >> 5, j = i & 31;
    float pos = (j < 16) ? (float)(t >> 6) : (float)(t & 63);
    float fr = powf(10000.f, -(float)(j & 15) / 16.f);
    float ang = pos * fr;
    rc[i] = cosf(ang);
    rs[i] = sinf(ang);
  }
  for (int i = gt; i < 4096 * 16; i += gs) {
    int t = i >> 4, j = i & 15;
    float pos = (j < 8) ? (float)(t >> 6) : (float)(t & 63);
    float fr = powf(10000.f, -(float)(j & 7) / 8.f);
    float ang = pos * fr;
    dc[i] = cosf(ang);
    ds[i] = sinf(ang);
  }
}

DI void transpose_tile(const float* __restrict__ src, int K, int N, bf16_t* __restrict__ dst, int kt, int nt, float* tile) {
  const int tid = tidx();
  const int k0 = kt * 64, n0 = nt * 64;
  {
    int nl = tid & 63, ks = tid >> 6;
#pragma unroll 4
    for (int i = 0; i < 16; ++i) {
      int kl = i * 4 + ks;
      int n = n0 + nl;
      tile[kl * 65 + nl] = (n < N) ? src[(size_t)(k0 + kl) * N + n] : 0.f;
    }
  }
  __syncthreads();
  {
    int kl = tid & 63, ns = tid >> 6;
#pragma unroll 4
    for (int i = 0; i < 16; ++i) {
      int nl = i * 4 + ns;
      dst[(size_t)(n0 + nl) * K + k0 + kl] = f2bf(tile[kl * 65 + nl]);
    }
  }
  __syncthreads();
}

DI void stage_w(const Params& p, int l, char* smem, int tstart, int tstride) {
  float* tile = (float*)smem;
  constexpr int T_IN = 16 * 56, T_OUT = 16 * 16, T_UP = 16 * 88, T_DN = 44 * 16;
  for (int task = tstart; task < T_IN + T_OUT + T_UP + T_DN; task += tstride) {
    int t = task;
    if (t < T_IN) {
      transpose_tile(p.in[I_WIN] + (size_t)l * D * PIN, D, PIN, (bf16_t*)(p.ws + WS_WIN), t % 16, t / 16, tile);
    } else if ((t -= T_IN) < T_OUT) {
      transpose_tile(p.in[I_WOUT] + (size_t)l * D * D, D, D, (bf16_t*)(p.ws + WS_WOUT), t % 16, t / 16, tile);
    } else if ((t -= T_OUT) < T_UP) {
      transpose_tile(p.in[I_FUP] + (size_t)l * D * FF2, D, FF2, (bf16_t*)(p.ws + WS_WUP), t % 16, t / 16, tile);
    } else {
      t -= T_UP;
      transpose_tile(p.in[I_FDN] + (size_t)l * FF * D, FF, D, (bf16_t*)(p.ws + WS_WDN), t % 44, t / 44, tile);
    }
  }
}

DI void stage_norm(const Params& p, int sid, int l, int which) {
  const int T = sid ? 4096 : 256;
  const int lane = tidx() & 63, wv = tidx() >> 6;
  const float* xin = (which == 0 && l == 0) ? p.in[sid ? I_XS : I_XP] : (p.out + (sid ? O_YS : O_YP));
  const float* g = p.in[which ? I_N2G : I_N1G] + l * D;
  const float* MOD = (const float*)(p.ws + WS_MOD);
  bf16_t* hb = (bf16_t*)(p.ws + WS_HBUF);
  for (int grp = blockIdx.x * 4 + wv; grp < NT / 4; grp += gridDim.x * 4) {
    const int tok0 = grp * 4;
    const int cond = sid ? 1 + tok0 / T : 0;
    const float* md = MOD + (size_t)(l * 3 + cond) * 6144 + which * 3072;
    float4 gs[4], sh[4];
#pragma unroll
    for (int i = 0; i < 4; ++i) {
      const int c = i * 256 + lane * 4;
      const float4 gg = *(const float4*)(g + c);
      const float4 sc = *(const float4*)(md + 1024 + c);
      sh[i] = *(const float4*)(md + c);
      gs[i] = make_float4(gg.x * (1.f + sc.x), gg.y * (1.f + sc.y), gg.z * (1.f + sc.z), gg.w * (1.f + sc.w));
    }
    float4 v[4][4];
#pragma unroll
    for (int k = 0; k < 4; ++k)
#pragma unroll
      for (int i = 0; i < 4; ++i) v[k][i] = *(const float4*)(xin + (size_t)(tok0 + k) * D + i * 256 + lane * 4);
#pragma unroll
    for (int k = 0; k < 4; ++k) {
      float ss = 0.f;
#pragma unroll
      for (int i = 0; i < 4; ++i) ss += v[k][i].x * v[k][i].x + v[k][i].y * v[k][i].y + v[k][i].z * v[k][i].z + v[k][i].w * v[k][i].w;
      ss = wave_sum(ss);
      const float rstd = rsqrtf(ss * (1.f / 1024.f) + 1e-6f);
#pragma unroll
      for (int i = 0; i < 4; ++i) {
        const int c = i * 256 + lane * 4;
        uint2 pk;
        pk.x = pack2(v[k][i].x * rstd * gs[i].x + sh[i].x, v[k][i].y * rstd * gs[i].y + sh[i].y);
        pk.y = pack2(v[k][i].z * rstd * gs[i].z + sh[i].z, v[k][i].w * rstd * gs[i].w + sh[i].w);
        *(uint2*)(hb + (size_t)(tok0 + k) * D + c) = pk;
      }
    }
  }
}

DI void stage_final(const Params& p) {
  const int lane = tidx() & 63, wv = tidx() >> 6;
  const float* g = p.in[I_NFG];
  float4 gf[4];
#pragma unroll
  for (int i = 0; i < 4; ++i) gf[i] = *(const float4*)(g + i * 256 + lane * 4);
#pragma unroll 2
  for (int tok = blockIdx.x * 4 + wv; tok < 2 * NT; tok += gridDim.x * 4) {
    float* xr = p.out + (size_t)tok * D;
    float4 v[4];
    float ss = 0.f;
#pragma unroll
    for (int i = 0; i < 4; ++i) {
      v[i] = *(const float4*)(xr + i * 256 + lane * 4);
      ss += v[i].x * v[i].x + v[i].y * v[i].y + v[i].z * v[i].z + v[i].w * v[i].w;
    }
    ss = wave_sum(ss);
    float rstd = rsqrtf(ss * (1.f / 1024.f) + 1e-6f);
#pragma unroll
    for (int i = 0; i < 4; ++i) {
      int c = i * 256 + lane * 4;
      float4 gg = gf[i];
      float4 o;
      o.x = v[i].x * rstd * gg.x;
      o.y = v[i].y * rstd * gg.y;
      o.z = v[i].z * rstd * gg.z;
      o.w = v[i].w * rstd * gg.w;
      *(float4*)(xr + c) = o;
    }
  }
}

DI int first_task(int base) {
  int g = (int)gridDim.x;
  int d = ((int)blockIdx.x - base) % g;
  if (d < 0) d += g;
  return base + d;
}

template <class Epi>
DI void gemm_tile_128(const bf16_t* __restrict__ A, int lda, const bf16_t* __restrict__ Bt, int ldb, int K, int m0, int n0,
                      char* smem, Epi epi) {
  bf16_t* sA = (bf16_t*)smem;
  bf16_t* sB = sA + 2 * 5120;
  const int tid = tidx(), lane = tid & 63, wid = tid >> 6, wm = wid >> 1, wn = wid & 1;
  const int r = lane & 31, hf = lane >> 5;
  f32x16 acc[2][2];
#pragma unroll
  for (int a = 0; a < 2; ++a)
#pragma unroll
    for (int b = 0; b < 2; ++b)
#pragma unroll
      for (int i = 0; i < 16; ++i) acc[a][b][i] = 0.f;
  const int lrow = tid >> 2, lkc = tid & 3;
  const bf16_t* ga = A + (size_t)(m0 + lrow) * lda + lkc * 8;
  const bf16_t* gb = Bt + (size_t)(n0 + lrow) * ldb + lkc * 8;
  const size_t a64 = (size_t)64 * lda, b64 = (size_t)64 * ldb;
  const int so = lrow * 40 + lkc * 8;
  uint4 ra0_0, ra1_0, rb0_0, rb1_0, ra0_1, ra1_1, rb0_1, rb1_1, ra0_2, ra1_2, rb0_2, rb1_2, ra0_3, ra1_3, rb0_3, rb1_3;
#define GL(n, kk)                                   \
  {                                                 \
    ra0_##n = *(const uint4*)(ga + (kk));           \
    ra1_##n = *(const uint4*)(ga + a64 + (kk));     \
    rb0_##n = *(const uint4*)(gb + (kk));           \
    rb1_##n = *(const uint4*)(gb + b64 + (kk));     \
  }
#define ST(n, buf)                                            \
  {                                                           \
    *(uint4*)(sA + (buf) * 5120 + so) = ra0_##n;              \
    *(uint4*)(sA + (buf) * 5120 + so + 64 * 40) = ra1_##n;    \
    *(uint4*)(sB + (buf) * 5120 + so) = rb0_##n;              \
    *(uint4*)(sB + (buf) * 5120 + so + 64 * 40) = rb1_##n;    \
  }
#define COMPUTE(buf)                                                          \
  {                                                                           \
    const bf16_t* cA = sA + (buf) * 5120 + (wm * 64 + r) * 40 + hf * 8;       \
    const bf16_t* cB = sB + (buf) * 5120 + (wn * 64 + r) * 40 + hf * 8;       \
    _Pragma("unroll") for (int s = 0; s < 2; ++s) {                           \
      bf16x8 a0 = *(const bf16x8*)(cA + s * 16);                              \
      bf16x8 a1 = *(const bf16x8*)(cA + 32 * 40 + s * 16);                    \
      bf16x8 b0 = *(const bf16x8*)(cB + s * 16);                              \
      bf16x8 b1 = *(const bf16x8*)(cB + 32 * 40 + s * 16);                    \
      acc[0][0] = MFMA32(a0, b0, acc[0][0]);                                  \
      acc[0][1] = MFMA32(a0, b1, acc[0][1]);                                  \
      acc[1][0] = MFMA32(a1, b0, acc[1][0]);                                  \
      acc[1][1] = MFMA32(a1, b1, acc[1][1]);                                  \
    }                                                                         \
  }
  const int KT = K >> 5;
  GL(0, 0) GL(1, 32) GL(2, 64) GL(3, 96)
  ST(0, 0)
  GL(0, 128)
  lds_barrier();
  for (int kt = 0; kt < KT; kt += 4) {
    COMPUTE(0)
    ST(1, 1)
    if (kt + 5 < KT) GL(1, (kt + 5) << 5)
    lds_barrier();
    COMPUTE(1)
    ST(2, 0)
    if (kt + 6 < KT) GL(2, (kt + 6) << 5)
    lds_barrier();
    COMPUTE(0)
    ST(3, 1)
    if (kt + 7 < KT) GL(3, (kt + 7) << 5)
    lds_barrier();
    COMPUTE(1)
    if (kt + 4 < KT) ST(0, 0)
    if (kt + 8 < KT) GL(0, (kt + 8) << 5)
    lds_barrier();
  }
#undef GL
#undef ST
#undef COMPUTE
#pragma unroll
  for (int mt = 0; mt < 2; ++mt)
#pragma unroll
    for (int nt = 0; nt < 2; ++nt) {
#pragma unroll
      for (int i = 0; i < 16; ++i) {
        int row = m0 + wm * 64 + mt * 32 + crow(i, hf);
        int col = n0 + wn * 64 + nt * 32 + r;
        epi(row, col, acc[mt][nt][i]);
      }
      __builtin_amdgcn_sched_barrier(0);
    }
}

DI void stage_g1(const Params& p, int sid, int l, char* smem, int tstart, int tstride) {
  const bf16_t* A = wsbf(p, WS_HBUF);
  const bf16_t* Bt = wsbf(p, WS_WIN);
  bf16_t* F = (bf16_t*)(p.ws + WS_F);
  float* ok = p.out + O_CK;
  float* ov = p.out + O_CV;
  const int MT = NT / 128, NTL = PINP / 128;
  for (int tile = tstart; tile < MT * NTL; tile += tstride) {
    int mt = tile % MT, nt = tile / MT;
    gemm_tile_128(A, D, Bt, D, D, mt * 128, nt * 128, smem, [=](int row, int col, float v) __attribute__((always_inline)) {
      if (col < PIN) {
        F[(size_t)row * PIN + col] = f2bf(v);
        if (sid == 0 && col >= OD + 256) {
          int b = row >> 8, t = row & 255;
          size_t base = ((size_t)(b * 2 + l) * 256 + t) * 256;
          if (col < OD + 512) ok[base + (col - (OD + 256))] = v;
          else ov[base + (col - (OD + 512))] = v;
        }
      }
    });
  }
}

DI void stage_g2(const Params& p, int sid, int l, char* smem) {
  const int T = sid ? 4096 : 256;
  const bf16_t* A = wsbf(p, WS_CAT);
  const bf16_t* Bt = wsbf(p, WS_WOUT);
  const float* xin = (l == 0) ? p.in[sid ? I_XS : I_XP] : (p.out + (sid ? O_YS : O_YP));
  float* xo = p.out + (sid ? O_YS : O_YP);
  const float* MOD = (const float*)(p.ws + WS_MOD);
  const int MT = NT / 128, NTL = D / 128;
  for (int tile = blockIdx.x; tile < MT * NTL; tile += gridDim.x) {
    int mt = tile % MT, nt = tile / MT;
    int cond = sid ? 1 + (mt * 128) / T : 0;
    const float* gate = MOD + (size_t)(l * 3 + cond) * 6144 + 2048;
    gemm_tile_128(A, D, Bt, D, D, mt * 128, nt * 128, smem, [=](int row, int col, float v) __attribute__((always_inline)) {
      size_t idx = (size_t)row * D + col;
      xo[idx] = xin[idx] + gate[col] * v;
    });
  }
}

DI void stage_g3(const Params& p, char* smem) {
  const bf16_t* A = wsbf(p, WS_HBUF);
  const bf16_t* Bt = wsbf(p, WS_WUP);
  bf16_t* U = (bf16_t*)(p.ws + WS_U);
  const int MT = NT / 128, NTL = FF2 / 128;
  for (int tile = blockIdx.x; tile < MT * NTL; tile += gridDim.x) {
    int mt = tile % MT, nt = tile / MT;
    gemm_tile_128(A, D, Bt, D, D, mt * 128, nt * 128, smem,
                  [=](int row, int col, float v) __attribute__((always_inline)) { U[(size_t)row * FF2 + col] = f2bf(v); });
  }
}

DI void stage_g4(const Params& p, int sid, int l, char* smem) {
  const int T = sid ? 4096 : 256;
  const bf16_t* A = wsbf(p, WS_ACT);
  const bf16_t* Bt = wsbf(p, WS_WDN);
  float* xo = p.out + (sid ? O_YS : O_YP);
  const float* MOD = (const float*)(p.ws + WS_MOD);
  const int MT = NT / 128, NTL = D / 128;
  for (int tile = blockIdx.x; tile < MT * NTL; tile += gridDim.x) {
    int mt = tile % MT, nt = tile / MT;
    int cond = sid ? 1 + (mt * 128) / T : 0;
    const float* gate = MOD + (size_t)(l * 3 + cond) * 6144 + 5120;
    gemm_tile_128(A, FF, Bt, FF, FF, mt * 128, nt * 128, smem, [=](int row, int col, float v) __attribute__((always_inline)) {
      size_t idx = (size_t)row * D + col;
      xo[idx] = xo[idx] + gate[col] * v;
    });
  }
}

DI void stage_conv(const Params& p, int sid, int l) {
  const int T = sid ? 4096 : 256;
  const bf16_t* U = wsbf(p, WS_U);
  bf16_t* ACT = (bf16_t*)(p.ws + WS_ACT);
  const float* cw = p.in[I_FCW] + (size_t)l * 3 * FF2;
  const float* cb = p.in[I_FCB] + (size_t)l * FF2;
  const int NG = FF / 8;
  const size_t total = (size_t)(NT / 8) * NG;
  for (size_t i = (size_t)blockIdx.x * 256 + tidx(); i < total; i += (size_t)gridDim.x * 256) {
    const int tq = (int)(i / NG), j0 = (int)(i % NG) * 8;
    const int tok0 = tq * 8;
    const int t = tok0 % T;
    float wg[3][8], wv[3][8];
#pragma unroll
    for (int tap = 0; tap < 3; ++tap) {
      const float* wp = cw + tap * FF2 + j0;
      const float4 a0 = *(const float4*)(wp), a1 = *(const float4*)(wp + 4);
      const float4 b0 = *(const float4*)(wp + FF), b1 = *(const float4*)(wp + FF + 4);
      wg[tap][0] = a0.x; wg[tap][1] = a0.y; wg[tap][2] = a0.z; wg[tap][3] = a0.w;
      wg[tap][4] = a1.x; wg[tap][5] = a1.y; wg[tap][6] = a1.z; wg[tap][7] = a1.w;
      wv[tap][0] = b0.x; wv[tap][1] = b0.y; wv[tap][2] = b0.z; wv[tap][3] = b0.w;
      wv[tap][4] = b1.x; wv[tap][5] = b1.y; wv[tap][6] = b1.z; wv[tap][7] = b1.w;
    }
    float g[8][8], v[8][8];
    {
      const float4 a0 = *(const float4*)(cb + j0), a1 = *(const float4*)(cb + j0 + 4);
      const float4 b0 = *(const float4*)(cb + FF + j0), b1 = *(const float4*)(cb + FF + j0 + 4);
#pragma unroll
      for (int o = 0; o < 8; ++o) {
        g[o][0] = a0.x; g[o][1] = a0.y; g[o][2] = a0.z; g[o][3] = a0.w;
        g[o][4] = a1.x; g[o][5] = a1.y; g[o][6] = a1.z; g[o][7] = a1.w;
        v[o][0] = b0.x; v[o][1] = b0.y; v[o][2] = b0.z; v[o][3] = b0.w;
        v[o][4] = b1.x; v[o][5] = b1.y; v[o][6] = b1.z; v[o][7] = b1.w;
      }
    }
#pragma unroll
    for (int r = -1; r <= 8; ++r) {
      const int tt = t + r;
      if (tt < 0 || tt >= T) continue;
      const bf16_t* ur = U + (size_t)(tok0 + r) * FF2 + j0;
      const bf16x8 ug = *(const bf16x8*)(ur);
      const bf16x8 uv = *(const bf16x8*)(ur + FF);
      float fg[8], fv[8];
#pragma unroll
      for (int e = 0; e < 8; ++e) { fg[e] = bf2f((bf16_t)ug[e]); fv[e] = bf2f((bf16_t)uv[e]); }
#pragma unroll
      for (int o = 0; o < 8; ++o) {
        const int tap = r - o + 1;
        if (tap >= 0 && tap <= 2) {
#pragma unroll
          for (int e = 0; e < 8; ++e) {
            g[o][e] += wg[tap][e] * fg[e];
            v[o][e] += wv[tap][e] * fv[e];
          }
        }
      }
    }
#pragma unroll
    for (int o = 0; o < 8; ++o) {
      uint4 q;
      q.x = pack2(silu_f(g[o][0]) * v[o][0], silu_f(g[o][1]) * v[o][1]);
      q.y = pack2(silu_f(g[o][2]) * v[o][2], silu_f(g[o][3]) * v[o][3]);
      q.z = pack2(silu_f(g[o][4]) * v[o][4], silu_f(g[o][5]) * v[o][5]);
      q.w = pack2(silu_f(g[o][6]) * v[o][6], silu_f(g[o][7]) * v[o][7]);
      *(uint4*)(ACT + (size_t)(tok0 + o) * FF + j0) = q;
    }
  }
}

DI void stage_prep(const Params& p, int sid, int l, char* smem) {
  const int T = sid ? 4096 : 256;
  const int NK = sid ? 4608 : 256;
  float* fs = (float*)smem;
  const int tid = tidx();
  const int c = tid;
  const bf16_t* F = wsbf(p, WS_F);
  h16* FRW = (h16*)(p.ws + WS_FEED_RW);
  h16* FRET = (h16*)(p.ws + WS_FEED_RET);
  h16* FSSD = (h16*)(p.ws + WS_FEED_SSD);
  float* DTG = (float*)(p.ws + WS_DTG);
  h16* RG = (h16*)(p.ws + WS_RG);
  h16* BON = (h16*)(p.ws + WS_BONUS);
  bf16_t* KR = (bf16_t*)(p.ws + WS_KR);
  bf16_t* VT = (bf16_t*)(p.ws + WS_VT);
  bf16_t* QGZ = (bf16_t*)(p.ws + WS_QGZ);
  const float* mu = p.in[I_MU] + l * 960;
  const float* wup = p.in[I_WUP] + (size_t)l * 2 * 32 * 256;
  const float* aup = p.in[I_AUP] + (size_t)l * 2 * 32 * 256;
  const float* gup = p.in[I_GUP] + (size_t)l * 64 * 256;
  const float* rcs = (const float*)(p.ws + WS_ROPE_RET);
  const float* rsn = rcs + 4096 * 32;
  const float* dcs = (const float*)(p.ws + WS_ROPE_DIF);
  const float* dsn = dcs + 4096 * 16;
  const int ntask = NT / 8 + (sid ? 128 : 0);
  for (int task = blockIdx.x; task < ntask; task += gridDim.x) {
    if (task >= NT / 8) {
      int tg = task - NT / 8;
      int b = tg >> 6, p0 = (tg & 63) * 8;
      int hh = c >> 6, m = (c >> 5) & 1, d = c & 31, e = c & 63;
      const float* ck = p.in[I_CK] + ((size_t)(b * 2 + l) * 512 + p0) * 256 + c;
      const float* cv = p.in[I_CV] + ((size_t)(b * 2 + l) * 512 + p0) * 256 + c;
      float vv[8];
#pragma unroll
      for (int tl = 0; tl < 8; ++tl) {
        KR[((size_t)((b * 4 + hh) * 2 + m) * NK + 4096 + p0 + tl) * 32 + d] = f2bf(ck[tl * 256]);
        vv[tl] = cv[tl * 256];
      }
      uint4 o;
      o.x = pack2(vv[0], vv[1]);
      o.y = pack2(vv[2], vv[3]);
      o.z = pack2(vv[4], vv[5]);
      o.w = pack2(vv[6], vv[7]);
      *(uint4*)(VT + ((size_t)(b * 4 + hh) * 64 + e) * NK + 4096 + p0) = o;
      continue;
    }
    const int tok0 = task * 8;
    const int seq = tok0 / T, t0 = tok0 % T;
    if (tid < 240) {
      const int qd = tid / 120, g8 = tid - qd * 120;
      const int cc = g8 * 8;
      const int tb = t0 + qd * 4;
      const bf16_t* fr = F + (size_t)(tok0 + qd * 4) * PIN + cc;
      bf16x8 rows[6];
#pragma unroll
      for (int r = 0; r < 6; ++r) {
        const int tr = tb + r - 1;
        bf16x8 z8 = {0, 0, 0, 0, 0, 0, 0, 0};
        rows[r] = z8;
        if (tr >= 0 && tr < T) rows[r] = *(const bf16x8*)(fr + (long)(r - 1) * PIN);
      }
      const float4 m0 = *(const float4*)(mu + cc), m1 = *(const float4*)(mu + cc + 4);
      const float mm[8] = {m0.x, m0.y, m0.z, m0.w, m1.x, m1.y, m1.z, m1.w};
#pragma unroll
      for (int o4 = 0; o4 < 4; ++o4) {
        float o[8];
#pragma unroll
        for (int e = 0; e < 8; ++e) {
          float c_ = bf2f((bf16_t)rows[o4 + 1][e]);
          float p_ = bf2f((bf16_t)rows[o4][e]);
          float n_ = bf2f((bf16_t)rows[o4 + 2][e]);
          float v = c_ + mm[e] * (0.5f * (p_ + n_) - c_);
          if (cc >= 768 && cc < 832) v = tanh_f(v);
          else if (cc >= 896) v = sigmoid_f(v);
          o[e] = v;
        }
        float* dst = fs + (qd * 4 + o4) * 960 + cc;
        *(float4*)(dst) = make_float4(o[0], o[1], o[2], o[3]);
        *(float4*)(dst + 4) = make_float4(o[4], o[5], o[6], o[7]);
      }
    }
    __syncthreads();
#pragma unroll 1
    for (int hb = 0; hb < 2; ++hb) {
      const float* fsb = fs + hb * 4 * 960;
      float aw0[4], aw1[4], aa0[4], aa1[4], ag[4];
#pragma unroll
      for (int tl = 0; tl < 4; ++tl) { aw0[tl] = 0.f; aw1[tl] = 0.f; aa0[tl] = 0.f; aa1[tl] = 0.f; ag[tl] = 0.f; }
#pragma unroll 8
      for (int rr = 0; rr < 32; ++rr) {
        float wu0 = wup[rr * 256 + c], wu1 = wup[(32 + rr) * 256 + c];
        float au0 = aup[rr * 256 + c], au1 = aup[(32 + rr) * 256 + c];
#pragma unroll
        for (int tl = 0; tl < 4; ++tl) {
          const float* fr = fsb + tl * 960;
          aw0[tl] += fr[768 + rr] * wu0;
          aw1[tl] += fr[800 + rr] * wu1;
          aa0[tl] += fr[832 + rr] * au0;
          aa1[tl] += fr[864 + rr] * au1;
        }
      }
#pragma unroll 16
      for (int jj = 0; jj < 64; ++jj) {
        float gu = gup[jj * 256 + c];
#pragma unroll
        for (int tl = 0; tl < 4; ++tl) ag[tl] += fsb[tl * 960 + 896 + jj] * gu;
      }
      const float w00 = p.in[I_W0][(l * 2 + 0) * 256 + c], w01 = p.in[I_W0][(l * 2 + 1) * 256 + c];
      const float a00 = p.in[I_A0][(l * 2 + 0) * 256 + c], a01 = p.in[I_A0][(l * 2 + 1) * 256 + c];
      const float kkc = p.in[I_KK][l * 256 + c], kac = p.in[I_KA][l * 256 + c], rkc = p.in[I_RK][l * 256 + c];
#pragma unroll
      for (int tl = 0; tl < 4; ++tl) {
        const float* fr = fsb + tl * 960;
        float r = fr[c], k = fr[256 + c], v = fr[512 + c];
        float kkv = k * kkc;
        float ss = wave_sum(kkv * kkv);
        float kkn = kkv * rsqrtf(fmaxf(ss, 1e-12f));
        float bs = wave_sum(r * k * rkc);
        size_t tok = (size_t)(tok0 + hb * 4 + tl);
        h16* o = FRW + tok * 2304 + c;
        o[0] = (h16)r;
        o[256] = (h16)v;
        o[512] = (h16)kkn;
        {
          float x = w00 + aw0[tl];
          float dec = fexp(-fexp(-softplus_f(-x) - 0.5f));
          float a = sigmoid_f(a00 + aa0[tl]);
          o[3 * 256] = (h16)dec;
          o[4 * 256] = (h16)(k * (1.f + (a - 1.f) * kac));
          o[5 * 256] = (h16)(kkn * a);
        }
        {
          float x = w01 + aw1[tl];
          float dec = fexp(-fexp(-softplus_f(-x) - 0.5f));
          float a = sigmoid_f(a01 + aa1[tl]);
          o[6 * 256] = (h16)dec;
          o[7 * 256] = (h16)(k * (1.f + (a - 1.f) * kac));
          o[8 * 256] = (h16)(kkn * a);
        }
        RG[tok * 256 + c] = (h16)ag[tl];
        BON[tok * 256 + c] = (h16)(bs * v);
      }
    }
    {
      const int tl = tid >> 5, c8 = (tid & 31) * 8;
      const size_t tok = (size_t)(tok0 + tl);
      const int t = t0 + tl;
      {
        const bf16_t* fr = F + tok * PIN + OB;
        const int i64 = c8 & 63;
        const int c8p = (i64 < 32) ? c8 + 32 : c8 - 32;
        const bf16x8 q8 = *(const bf16x8*)(fr + c8), k8 = *(const bf16x8*)(fr + 256 + c8), v8 = *(const bf16x8*)(fr + 512 + c8);
        float qf[8], kf[8];
#pragma unroll
        for (int e = 0; e < 8; ++e) { qf[e] = bf2f((bf16_t)q8[e]); kf[e] = bf2f((bf16_t)k8[e]); }
        if (sid) {
          const bf16x8 qp8 = *(const bf16x8*)(fr + c8p), kp8 = *(const bf16x8*)(fr + 256 + c8p);
          const float* cpt = rcs + t * 32 + (i64 & 31);
          const float* spt = rsn + t * 32 + (i64 & 31);
          const float4 ca = *(const float4*)cpt, cb4 = *(const float4*)(cpt + 4);
          const float4 sa4 = *(const float4*)spt, sb4 = *(const float4*)(spt + 4);
          const float cs[8] = {ca.x, ca.y, ca.z, ca.w, cb4.x, cb4.y, cb4.z, cb4.w};
          const float sn[8] = {sa4.x, sa4.y, sa4.z, sa4.w, sb4.x, sb4.y, sb4.z, sb4.w};
#pragma unroll
          for (int e = 0; e < 8; ++e) {
            float qp = bf2f((bf16_t)qp8[e]), kp = bf2f((bf16_t)kp8[e]);
            if (i64 < 32) { qf[e] = qf[e] * cs[e] - qp * sn[e]; kf[e] = kf[e] * cs[e] - kp * sn[e]; }
            else { qf[e] = qf[e] * cs[e] + qp * sn[e]; kf[e] = kf[e] * cs[e] + kp * sn[e]; }
          }
        }
        h16x8 oq, ok_, ov_;
#pragma unroll
        for (int e = 0; e < 8; ++e) { oq[e] = (h16)qf[e]; ok_[e] = (h16)(kf[e] * 0.125f); ov_[e] = (h16)bf2f((bf16_t)v8[e]); }
        h16* o = FRET + tok * 768 + c8;
        *(h16x8*)(o) = oq;
        *(h16x8*)(o + 256) = ok_;
        *(h16x8*)(o + 512) = ov_;
      }
      {
        const bf16_t* fr = F + tok * PIN + OD;
        const int hh = c8 >> 6, m = (c8 >> 5) & 1, d8 = c8 & 31;
        const int c8p = (d8 < 16) ? c8 + 16 : c8 - 16;
        const bf16x8 k8 = *(const bf16x8*)(fr + 256 + c8), q8 = *(const bf16x8*)(fr + c8);
        float kf[8], qf[8];
#pragma unroll
        for (int e = 0; e < 8; ++e) { kf[e] = bf2f((bf16_t)k8[e]); qf[e] = bf2f((bf16_t)q8[e]); }
        if (sid) {
          const bf16x8 kp8 = *(const bf16x8*)(fr + 256 + c8p), qp8 = *(const bf16x8*)(fr + c8p);
          const float* cpt = dcs + t * 16 + (d8 & 15);
          const float* spt = dsn + t * 16 + (d8 & 15);
          const float4 ca = *(const float4*)cpt, cb4 = *(const float4*)(cpt + 4);
          const float4 sa4 = *(const float4*)spt, sb4 = *(const float4*)(spt + 4);
          const float cs[8] = {ca.x, ca.y, ca.z, ca.w, cb4.x, cb4.y, cb4.z, cb4.w};
          const float sn[8] = {sa4.x, sa4.y, sa4.z, sa4.w, sb4.x, sb4.y, sb4.z, sb4.w};
#pragma unroll
          for (int e = 0; e < 8; ++e) {
            float kp = bf2f((bf16_t)kp8[e]), qp = bf2f((bf16_t)qp8[e]);
            if (d8 < 16) { kf[e] = kf[e] * cs[e] - kp * sn[e]; qf[e] = qf[e] * cs[e] - qp * sn[e]; }
            else { kf[e] = kf[e] * cs[e] + kp * sn[e]; qf[e] = qf[e] * cs[e] + qp * sn[e]; }
          }
        }
        uint4 ko, qo;
        ko.x = pack2(kf[0], kf[1]); ko.y = pack2(kf[2], kf[3]); ko.z = pack2(kf[4], kf[5]); ko.w = pack2(kf[6], kf[7]);
        qo.x = pack2(qf[0], qf[1]); qo.y = pack2(qf[2], qf[3]); qo.z = pack2(qf[4], qf[5]); qo.w = pack2(qf[6], qf[7]);
        *(uint4*)(KR + ((size_t)((seq * 4 + hh) * 2 + m) * NK + t) * 32 + d8) = ko;
        bf16_t* qg = QGZ + tok * 768 + c8;
        *(uint4*)(qg) = qo;
        *(uint4*)(qg + 256) = *(const uint4*)(F + tok * PIN + OB + 768 + c8);
        *(uint4*)(qg + 512) = *(const uint4*)(F + tok * PIN + OC + c8);
      }
    }
    {
      const float* cw = p.in[I_SCW] + (size_t)l * 3 * 512;
      const float* cb = p.in[I_SCB] + (size_t)l * 512;
#pragma unroll
      for (int it = 0; it < 2; ++it) {
        const int idx = tid + it * 256;
        const int tl = idx >> 6, cc8 = (idx & 63) * 8;
        const size_t tok = (size_t)(tok0 + tl);
        const int t = t0 + tl;
        const bf16_t* fr = F + tok * PIN + OC + 256 + cc8;
        const bf16x8 cur = *(const bf16x8*)fr;
        bf16x8 prv = cur, nxt = cur;
        if (t > 0) prv = *(const bf16x8*)(fr - PIN);
        if (t < T - 1) nxt = *(const bf16x8*)(fr + PIN);
        const float4 w0a = *(const float4*)(cw + cc8), w0b = *(const float4*)(cw + cc8 + 4);
        const float4 w1a = *(const float4*)(cw + 512 + cc8), w1b = *(const float4*)(cw + 512 + cc8 + 4);
        const float4 w2a = *(const float4*)(cw + 1024 + cc8), w2b = *(const float4*)(cw + 1024 + cc8 + 4);
        const float4 bba = *(const float4*)(cb + cc8), bbb = *(const float4*)(cb + cc8 + 4);
        const float w0[8] = {w0a.x, w0a.y, w0a.z, w0a.w, w0b.x, w0b.y, w0b.z, w0b.w};
        const float w1[8] = {w1a.x, w1a.y, w1a.z, w1a.w, w1b.x, w1b.y, w1b.z, w1b.w};
        const float w2[8] = {w2a.x, w2a.y, w2a.z, w2a.w, w2b.x, w2b.y, w2b.z, w2b.w};
        const float bb[8] = {bba.x, bba.y, bba.z, bba.w, bbb.x, bbb.y, bbb.z, bbb.w};
        h16x8 o;
#pragma unroll
        for (int e = 0; e < 8; ++e) {
          float acc = bb[e] + w1[e] * bf2f((bf16_t)cur[e]);
          if (t > 0) acc += w0[e] * bf2f((bf16_t)prv[e]);
          if (t < T - 1) acc += w2[e] * bf2f((bf16_t)nxt[e]);
          o[e] = (h16)silu_f(acc);
        }
        const int dst = (cc8 < 256) ? 256 + cc8 : ((cc8 < 384) ? 128 + (cc8 - 256) : (cc8 - 384));
        *(h16x8*)(FSSD + tok * 512 + dst) = o;
      }
      if (tid < 64) {
        int tl = tid >> 3, dh = tid & 7;
        size_t tok = (size_t)(tok0 + tl);
        float raw = bf2f(F[tok * PIN + OC + 768 + dh]) + p.in[I_DTB][l * 8 + dh];
        float dt = softplus_f(raw);
        float gm = fexp(-expf(p.in[I_ALOG][l * 8 + dh]) * dt);
        DTG[tok * 16 + dh * 2] = dt;
        DTG[tok * 16 + dh * 2 + 1] = gm;
      }
    }
    {
      const int hh = c >> 6, e = c & 63;
      unsigned short vv[8];
#pragma unroll
      for (int tl = 0; tl < 8; ++tl) vv[tl] = F[(size_t)(tok0 + tl) * PIN + OD + 512 + c];
      uint4 o;
      o.x = (unsigned)vv[0] | ((unsigned)vv[1] << 16);
      o.y = (unsigned)vv[2] | ((unsigned)vv[3] << 16);
      o.z = (unsigned)vv[4] | ((unsigned)vv[5] << 16);
      o.w = (unsigned)vv[6] | ((unsigned)vv[7] << 16);
      *(uint4*)(VT + ((size_t)(seq * 4 + hh) * 64 + e) * NK + t0) = o;
    }
    __syncthreads();
  }
}

template <int CTRL>
DI float dppx(float v) {
  return __builtin_bit_cast(float, __builtin_amdgcn_update_dpp(0, __builtin_bit_cast(int, v), CTRL, 0xf, 0xf, false));
}
template <int LPR>
DI float grp_sum(float v) {
  if (LPR == 16) {
    v += dppx<0x128>(v);
    v += dppx<0x124>(v);
    v += dppx<0x122>(v);
    v += dppx<0x121>(v);
  } else {
    v += dppx<0xB1>(v);
    v += dppx<0x4E>(v);
    v += dppx<0x141>(v);
  }
  return v;
}

template <int MIX, int KPL>
DI void scan_task(const Params& p, int sid, int l, int seq, int h, int dir, int q, float* lds) {
  constexpr int LPR = 64 / KPL;
  constexpr int R = (KPL == 8) ? 2 : 1;
  constexpr int RPW = (64 / LPR) * R;
  constexpr int RPB = 4 * RPW;
  constexpr int NV4 = KPL / 4;
  const int T = sid ? 4096 : 256;
  const int tid = tidx(), lane = tid & 63, wv = tid >> 6, j = lane % LPR, rw = lane / LPR;
  const int rowl = wv * RPW + rw * R;
  const int row = q * RPB + rowl;
  const size_t tokbase = (size_t)seq * T;
  const h16* feed;
  int ts, o0, o1, o2 = 0, o3 = 0, o4 = 0, ov;
  constexpr int NVEC = (MIX == 0) ? 5 : 2;
  if (MIX == 0) {
    feed = (const h16*)(p.ws + WS_FEED_RW);
    ts = 2304;
    o0 = 0 * 256 + h * 64;
    o1 = (4 + 3 * dir) * 256 + h * 64;
    o2 = 2 * 256 + h * 64;
    o3 = (3 + 3 * dir) * 256 + h * 64;
    o4 = (5 + 3 * dir) * 256 + h * 64;
    ov = 1 * 256 + h * 64 + q * RPB;
  } else if (MIX == 1) {
    feed = (const h16*)(p.ws + WS_FEED_RET);
    ts = 768;
    o0 = h * 64;
    o1 = 256 + h * 64;
    ov = 512 + h * 64 + q * RPB;
  } else {
    feed = (const h16*)(p.ws + WS_FEED_SSD);
    ts = 512;
    o0 = (h >> 1) * 64;
    o1 = 128 + (h >> 1) * 64;
    ov = 256 + h * 64 + q * RPB;
  }
  const float* DTG = (const float*)(p.ws + WS_DTG);
  float gconst = 1.f;
  if (MIX == 1) gconst = 1.f - exp2f(-(dir ? 5.5f : 5.0f) - (float)h);
  float S[R * KPL];
#pragma unroll
  for (int e = 0; e < R * KPL; ++e) S[e] = 0.f;
  if (sid) {
    size_t sb = ((size_t)((seq * 2 + l) * 2 + dir) * 4 + h) * 4096;
#pragma unroll
    for (int rr = 0; rr < R; ++rr) {
      if (MIX == 0) {
#pragma unroll
        for (int e4 = 0; e4 < NV4; ++e4) {
          float4 s4 = *(const float4*)(p.in[I_SRW] + sb + (row + rr) * 64 + KPL * j + 4 * e4);
          S[rr * KPL + 4 * e4 + 0] = s4.x; S[rr * KPL + 4 * e4 + 1] = s4.y;
          S[rr * KPL + 4 * e4 + 2] = s4.z; S[rr * KPL + 4 * e4 + 3] = s4.w;
        }
      } else {
        const float* sp = p.in[MIX == 1 ? I_SRET : I_SSSD] + sb + row + rr;
#pragma unroll
        for (int e = 0; e < KPL; ++e) S[rr * KPL + e] = sp[(KPL * j + e) * 64];
      }
    }
  }
  float* Y = (float*)(p.ws + WS_Y) + ((size_t)(MIX * 2 + dir) * NT + tokbase) * 256 + h * 64 + row;

  constexpr int NPV = RPB / 8;
  constexpr int NP = NVEC * 8 + NPV;
  constexpr int TOTAL = NP * TC;
  constexpr int NL = (TOTAL + 255) / 256;
  uint4 lr[2][NL];
  float2 lsc[2] = {make_float2(0.f, 0.f), make_float2(0.f, 0.f)};
  const h16* srcp[NL];
  int dsto[NL];
  bool lval[NL];
#pragma unroll
  for (int i = 0; i < NL; ++i) {
    int idx = tid + i * 256;
    lval[i] = idx < TOTAL;
    if (idx >= TOTAL) idx = TOTAL - 1;
    int s_ = idx / NP, pp = idx - s_ * NP;
    int off, dst;
    if (pp < NVEC * 8) {
      int vec = pp >> 3, part = pp & 7;
      off = (vec == 0 ? o0 : vec == 1 ? o1 : vec == 2 ? o2 : vec == 3 ? o3 : o4) + part * 8;
      dst = s_ * SST + vec * 64 + part * 8;
    } else {
      off = ov + (pp - NVEC * 8) * 8;
      dst = s_ * SST + 320 + (pp - NVEC * 8) * 8;
    }
    size_t tok = tokbase + (dir ? T - 1 - s_ : s_);
    srcp[i] = feed + tok * ts + off;
    dsto[i] = dst;
  }
  const long cstride = (long)(dir ? -TC : TC) * ts;
  const float* dtgp = DTG + (tokbase + (dir ? T - 1 - (tid & (TC - 1)) : (tid & (TC - 1)))) * 16 + (dir * 4 + h) * 2;
  const long dstride = (long)(dir ? -TC : TC) * 16;
#define SCAN_ISSUE(SET, CH)                                                                     \
  {                                                                                             \
    _Pragma("unroll") for (int i = 0; i < NL; ++i) {                                            \
      lr[SET][i] = *(const uint4*)(srcp[i] + (long)(CH) * cstride);                             \
    }                                                                                           \
    if (MIX == 2) lsc[SET] = *(const float2*)(dtgp + (long)(CH) * dstride);                     \
  }
#define SCAN_COMMIT(SET, BUF)                                                                   \
  {                                                                                             \
    float* Bw = lds + (BUF) * SBUF;                                                             \
    _Pragma("unroll") for (int i = 0; i < NL; ++i) {                                            \
      if (lval[i]) {                                                                            \
        h16x8 hv = __builtin_bit_cast(h16x8, lr[SET][i]);                                       \
        float4 a_, b_;                                                                          \
        a_.x = (float)hv[0]; a_.y = (float)hv[1]; a_.z = (float)hv[2]; a_.w = (float)hv[3];     \
        b_.x = (float)hv[4]; b_.y = (float)hv[5]; b_.z = (float)hv[6]; b_.w = (float)hv[7];     \
        *(float4*)(Bw + dsto[i]) = a_;                                                          \
        *(float4*)(Bw + dsto[i] + 4) = b_;                                                      \
      }                                                                                         \
    }                                                                                           \
    if (MIX == 2 && tid < TC) {                                                                 \
      Bw[tid * SST + 384] = lsc[SET].y;                                                         \
      Bw[tid * SST + 385] = lsc[SET].x;                                                         \
    }                                                                                           \
  }

  const int NCH = T / TC;
  SCAN_ISSUE(0, 0)
  SCAN_COMMIT(0, 0)
  SCAN_ISSUE(1, 1)
  __syncthreads();
  for (int ch2 = 0; ch2 < NCH; ch2 += 2) {
#pragma unroll
  for (int half = 0; half < 2; ++half) {
    const int ch = ch2 + half;
    const int buf = half;
    {
      const int chn = (ch + 2 < NCH) ? ch + 2 : NCH - 1;
      SCAN_ISSUE(half, chn)
    }
    const float* B = lds + buf * SBUF;
    float yp[R * TC];
    yp[0] = 0.f;
    if constexpr (KPL == 4) {
      const unsigned lb = (unsigned)(size_t)B;
      const unsigned a4 = lb + 16u * (unsigned)j;
      const unsigned a1 = lb + 4u * (unsigned)(320 + rowl);
      const unsigned a0 = lb + 4u * 384u;
      v2f_t Sa, Sb;
      Sa.x = S[0]; Sa.y = S[1]; Sb.x = S[2]; Sb.y = S[3];
      v4f_t QR[2][2], QK[2][2], QKK[2][2], QW[2][2], QB[2][2];
      float QV[2][2], QG[2][2], QDT[2][2];
#define DSR128(dst, base, OFF) asm volatile("ds_read_b128 %0, %1 offset:%2" : "=v"(dst) : "v"(base), "n"(OFF))
#define DSR32(dst, base, OFF) asm volatile("ds_read_b32 %0, %1 offset:%2" : "=v"(dst) : "v"(base), "n"(OFF))
#define LDS1(Z, U, S_)                                   \
  {                                                      \
    DSR128(QR[Z][U], a4, (S_) * SST * 4);                \
    DSR128(QK[Z][U], a4, (S_) * SST * 4 + 256);          \
    DSR32(QV[Z][U], a1, (S_) * SST * 4);                 \
    if (MIX == 0) {                                      \
      DSR128(QKK[Z][U], a4, (S_) * SST * 4 + 512);       \
      DSR128(QW[Z][U], a4, (S_) * SST * 4 + 768);        \
      DSR128(QB[Z][U], a4, (S_) * SST * 4 + 1024);       \
    }                                                    \
    if (MIX == 2) {                                      \
      DSR32(QG[Z][U], a0, (S_) * SST * 4);               \
      DSR32(QDT[Z][U], a0, (S_) * SST * 4 + 4);          \
    }                                                    \
  }
#define LDG(Z, G_) { LDS1(Z, 0, (G_) * 2 + 0) LDS1(Z, 1, (G_) * 2 + 1) }
#define WAITG(Z)                                                                                                     \
  {                                                                                                                  \
    if (MIX == 0) {                                                                                                  \
      asm volatile("s_waitcnt lgkmcnt(0)"                                                                            \
                   : "+v"(QR[Z][0]), "+v"(QR[Z][1]), "+v"(QK[Z][0]), "+v"(QK[Z][1]), "+v"(QKK[Z][0]),                \
                     "+v"(QKK[Z][1]), "+v"(QW[Z][0]), "+v"(QW[Z][1]), "+v"(QB[Z][0]), "+v"(QB[Z][1]),                \
                     "+v"(QV[Z][0]), "+v"(QV[Z][1])::"memory");                                                      \
    } else if (MIX == 1) {                                                                                           \
      asm volatile("s_waitcnt lgkmcnt(0)"                                                                            \
                   : "+v"(QR[Z][0]), "+v"(QR[Z][1]), "+v"(QK[Z][0]), "+v"(QK[Z][1]), "+v"(QV[Z][0]),                 \
                     "+v"(QV[Z][1])::"memory");                                                                      \
    } else {                                                                                                         \
      asm volatile("s_waitcnt lgkmcnt(0)"                                                                            \
                   : "+v"(QR[Z][0]), "+v"(QR[Z][1]), "+v"(QK[Z][0]), "+v"(QK[Z][1]), "+v"(QV[Z][0]), "+v"(QV[Z][1]), \
                     "+v"(QG[Z][0]), "+v"(QG[Z][1]), "+v"(QDT[Z][0]), "+v"(QDT[Z][1])::"memory");                    \
    }                                                                                                                \
  }
#define STEP4(Z, U, S_)                                                                             \
  {                                                                                                 \
    float vv = QV[Z][U];                                                                            \
    if (MIX == 0) {                                                                                 \
      v2f_t t2 = Sa * QKK[Z][U].xy + Sb * QKK[Z][U].zw;                                             \
      float sa = -grp_sum<16>(t2.x + t2.y);                                                         \
      Sa = (Sa * QW[Z][U].xy + vv * QK[Z][U].xy) + sa * QB[Z][U].xy;                                \
      Sb = (Sb * QW[Z][U].zw + vv * QK[Z][U].zw) + sa * QB[Z][U].zw;                                \
    } else {                                                                                        \
      float g = gconst;                                                                             \
      if (MIX == 2) { g = QG[Z][U]; vv *= QDT[Z][U]; }                                              \
      Sa = g * Sa + vv * QK[Z][U].xy;                                                               \
      Sb = g * Sb + vv * QK[Z][U].zw;                                                               \
    }                                                                                               \
    v2f_t y2 = Sa * QR[Z][U].xy + Sb * QR[Z][U].zw;                                                 \
    yp[S_] = y2.x + y2.y;                                                                           \
  }
#define GROUP4(Z, G_) { STEP4(Z, 0, (G_) * 2 + 0) STEP4(Z, 1, (G_) * 2 + 1) }
      LDG(0, 0)
      WAITG(0) LDG(1, 1) GROUP4(0, 0)
      WAITG(1) LDG(0, 2) GROUP4(1, 1)
      WAITG(0) LDG(1, 3) GROUP4(0, 2)
      WAITG(1) LDG(0, 4) GROUP4(1, 3)
      WAITG(0) LDG(1, 5) GROUP4(0, 4)
      WAITG(1) LDG(0, 6) GROUP4(1, 5)
      WAITG(0) LDG(1, 7) GROUP4(0, 6)
      WAITG(1) GROUP4(1, 7)
      S[0] = Sa.x; S[1] = Sa.y; S[2] = Sb.x; S[3] = Sb.y;
#undef DSR128
#undef DSR32
#undef LDS1
#undef LDG
#undef WAITG
#undef STEP4
#undef GROUP4
    } else {
    v2f_t Sv[R][4];
#pragma unroll
    for (int rr = 0; rr < R; ++rr)
#pragma unroll
      for (int e = 0; e < 4; ++e) { Sv[rr][e].x = S[rr * KPL + 2 * e]; Sv[rr][e].y = S[rr * KPL + 2 * e + 1]; }
    v4f_t nr[2], nk[2], nkk[2], nw[2], nb[2];
    float nvv[R], ng = 0.f, ndt = 0.f;
#pragma unroll
    for (int e = 0; e < 2; ++e) { nkk[e] = (v4f_t)(0.f); nw[e] = (v4f_t)(0.f); nb[e] = (v4f_t)(0.f); }
#define LD_VEC(dst, off_)                                                         \
  _Pragma("unroll") for (int e4 = 0; e4 < 2; ++e4) dst[e4] = *(const v4f_t*)(L + (off_) + KPL * j + 4 * e4);
#define LD_STEP(S_)                                  \
  {                                                  \
    const float* L = B + (S_) * SST;                 \
    LD_VEC(nr, 0)                                    \
    LD_VEC(nk, 64)                                   \
    _Pragma("unroll") for (int rr = 0; rr < R; ++rr) nvv[rr] = L[320 + rowl + rr]; \
    if (MIX == 0) {                                  \
      LD_VEC(nkk, 128)                               \
      LD_VEC(nw, 192)                                \
      LD_VEC(nb, 256)                                \
    }                                                \
    if (MIX == 2) {                                  \
      ng = L[384];                                   \
      ndt = L[385];                                  \
    }                                                \
  }
    LD_STEP(0)
#pragma unroll
    for (int s = 0; s < TC; ++s) {
      v4f_t r_[2], k_[2], kk_[2], w_[2], b_[2];
#pragma unroll
      for (int e = 0; e < 2; ++e) { r_[e] = nr[e]; k_[e] = nk[e]; kk_[e] = nkk[e]; w_[e] = nw[e]; b_[e] = nb[e]; }
      float vvr[R], g = ng, dtv = ndt;
#pragma unroll
      for (int rr = 0; rr < R; ++rr) vvr[rr] = nvv[rr];
      if (s + 1 < TC) LD_STEP(s + 1)
#pragma unroll
      for (int rr = 0; rr < R; ++rr) {
        float vv = vvr[rr];
        if (MIX == 0) {
          v2f_t ta = Sv[rr][0] * kk_[0].xy + Sv[rr][1] * kk_[0].zw;
          v2f_t tb = Sv[rr][2] * kk_[1].xy + Sv[rr][3] * kk_[1].zw;
          v2f_t t2 = ta + tb;
          float sa = -grp_sum<LPR>(t2.x + t2.y);
          Sv[rr][0] = (Sv[rr][0] * w_[0].xy + vv * k_[0].xy) + sa * b_[0].xy;
          Sv[rr][1] = (Sv[rr][1] * w_[0].zw + vv * k_[0].zw) + sa * b_[0].zw;
          Sv[rr][2] = (Sv[rr][2] * w_[1].xy + vv * k_[1].xy) + sa * b_[1].xy;
          Sv[rr][3] = (Sv[rr][3] * w_[1].zw + vv * k_[1].zw) + sa * b_[1].zw;
        } else {
          float gg = (MIX == 1) ? gconst : g;
          if (MIX == 2) vv *= dtv;
          Sv[rr][0] = gg * Sv[rr][0] + vv * k_[0].xy;
          Sv[rr][1] = gg * Sv[rr][1] + vv * k_[0].zw;
          Sv[rr][2] = gg * Sv[rr][2] + vv * k_[1].xy;
          Sv[rr][3] = gg * Sv[rr][3] + vv * k_[1].zw;
        }
        v2f_t ya = Sv[rr][0] * r_[0].xy + Sv[rr][1] * r_[0].zw;
        v2f_t yb = Sv[rr][2] * r_[1].xy + Sv[rr][3] * r_[1].zw;
        v2f_t y2 = ya + yb;
        yp[rr * TC + s] = y2.x + y2.y;
      }
    }
#pragma unroll
    for (int rr = 0; rr < R; ++rr)
#pragma unroll
      for (int e = 0; e < 4; ++e) { S[rr * KPL + 2 * e] = Sv[rr][e].x; S[rr * KPL + 2 * e + 1] = Sv[rr][e].y; }
    }
#undef LD_STEP
#undef LD_VEC
#define BFLY(YP_, N_, BIT_, CTRL_)                                    \
  _Pragma("unroll") for (int i = 0; i < (N_) / 2; ++i) {              \
    float lo = (YP_)[i], hi = (YP_)[i + (N_) / 2];                    \
    float keep = (BIT_) ? hi : lo, send = (BIT_) ? lo : hi;           \
    (YP_)[i] = keep + dppx<CTRL_>(send);                              \
  }
    if (LPR == 16) {
      BFLY(yp, 16, (j & 8), 0x140)
      BFLY(yp, 8, (j & 4), 0x141)
      BFLY(yp, 4, (j & 2), 0x1B)
      BFLY(yp, 2, (j & 1), 0xB1)
      int sg = ch * TC + j;
      int t = dir ? T - 1 - sg : sg;
      Y[(size_t)t * 256] = yp[0];
    } else {
#pragma unroll
      for (int rr = 0; rr < R; ++rr) {
        float* ypr = yp + rr * TC;
        BFLY(ypr, 16, (j & 4), 0x141)
        BFLY(ypr, 8, (j & 2), 0x1B)
        BFLY(ypr, 4, (j & 1), 0xB1)
        int sg = ch * TC + 2 * j;
        int t0_ = dir ? T - 1 - sg : sg;
        int t1_ = dir ? t0_ - 1 : t0_ + 1;
        Y[(size_t)t0_ * 256 + rr] = ypr[0];
        Y[(size_t)t1_ * 256 + rr] = ypr[1];
      }
    }
#undef BFLY
    if (ch + 1 < NCH) SCAN_COMMIT(half ^ 1, half ^ 1)
    lds_barrier();
  }
  }
#undef SCAN_ISSUE
#undef SCAN_COMMIT
  if (sid == 0) {
    size_t sb = ((size_t)((seq * 2 + l) * 2 + dir) * 4 + h) * 4096;
#pragma unroll
    for (int rr = 0; rr < R; ++rr) {
      if (MIX == 0) {
#pragma unroll
        for (int e4 = 0; e4 < NV4; ++e4)
          *(float4*)(p.out + O_SRW + sb + (row + rr) * 64 + KPL * j + 4 * e4) =
              make_float4(S[rr * KPL + 4 * e4 + 0], S[rr * KPL + 4 * e4 + 1], S[rr * KPL + 4 * e4 + 2], S[rr * KPL + 4 * e4 + 3]);
      } else {
        float* sp = p.out + (MIX == 1 ? O_SRET : O_SSSD) + sb + row + rr;
#pragma unroll
        for (int e = 0; e < KPL; ++e) sp[(KPL * j + e) * 64] = S[rr * KPL + e];
      }
    }
  }
}

DI void attn_task(const Params& p, int sid, int l, int seq, int h, int qb) {
  const int T = sid ? 4096 : 256;
  const int NK = sid ? 4608 : 256;
  const int lane = tidx() & 63, wv = tidx() >> 6;
  const int r = lane & 31, hf = lane >> 5;
  const int tq = qb * 128 + wv * 32 + r;
  const size_t tok = (size_t)seq * T + tq;
  const bf16_t* F = wsbf(p, WS_F);
  float lam_init = 0.8f - 0.6f * expf(-0.3f * (float)l);
  float lam;
  {
    const float* lp = opaque(p.in[I_DLAM] + l * 128);
    float s01 = wave_sum(lp[lane & 31] * lp[32 + (lane & 31)]) * 0.5f;
    float s23 = wave_sum(lp[64 + (lane & 31)] * lp[96 + (lane & 31)]) * 0.5f;
    lam = expf(s01) - expf(s23) + lam_init;
    asm volatile("" : "+v"(lam));
  }
  bf16x8 qf[2][2];
  {
    const bf16_t* fq = wsbf(p, WS_QGZ) + tok * 768 + h * 64;
#pragma unroll
    for (int m = 0; m < 2; ++m) {
      qf[m][0] = *(const bf16x8*)(fq + m * 32 + 8 * hf);
      qf[m][1] = *(const bf16x8*)(fq + m * 32 + 16 + 8 * hf);
    }
  }
  const bf16_t* Kb = wsbf(p, WS_KR) + (size_t)(seq * 4 + h) * 2 * NK * 32;
  const bf16_t* Vb = wsbf(p, WS_VT) + (size_t)(seq * 4 + h) * 64 * NK;
  f32x16 O[2][2];
#pragma unroll
  for (int a = 0; a < 2; ++a)
#pragma unroll
    for (int b = 0; b < 2; ++b)
#pragma unroll
      for (int i = 0; i < 16; ++i) O[a][b][i] = 0.f;
  float mx[2] = {-1e30f, -1e30f}, ls[2] = {0.f, 0.f};
  const float sc = 0.17677669529663687f * 1.4426950408889634f;
  const int NKT = NK / 32;
#pragma unroll 1
  for (int kt = 0; kt < NKT; ++kt) {
    bf16x8 vf[2][2];
#pragma unroll
    for (int mt = 0; mt < 2; ++mt)
#pragma unroll
      for (int s = 0; s < 2; ++s) {
        const bf16_t* vp = Vb + (size_t)(mt * 32 + r) * NK + kt * 32 + 16 * s + 4 * hf;
        uint2 lo = *(const uint2*)vp;
        uint2 hi = *(const uint2*)(vp + 8);
        uint4 cmb = make_uint4(lo.x, lo.y, hi.x, hi.y);
        vf[mt][s] = __builtin_bit_cast(bf16x8, cmb);
      }
#pragma unroll
    for (int m = 0; m < 2; ++m) {
      f32x16 S;
#pragma unroll
      for (int i = 0; i < 16; ++i) S[i] = 0.f;
#pragma unroll
      for (int s = 0; s < 2; ++s) {
        bf16x8 kf = *(const bf16x8*)(Kb + ((size_t)m * NK + kt * 32 + r) * 32 + 16 * s + 8 * hf);
        S = MFMA32(kf, qf[m][s], S);
      }
      float tmax = S[0];
#pragma unroll
      for (int i = 1; i < 16; ++i) tmax = fmaxf(tmax, S[i]);
      tmax = fmaxf(tmax, __shfl_xor(tmax, 32));
      float mnew = fmaxf(mx[m], tmax * sc);
      float alpha = exp2f(mx[m] - mnew);
      mx[m] = mnew;
      float psum = 0.f;
#pragma unroll
      for (int i = 0; i < 16; ++i) {
        S[i] = exp2f(S[i] * sc - mnew);
        psum += S[i];
      }
      ls[m] = ls[m] * alpha + psum;
#pragma unroll
      for (int mt = 0; mt < 2; ++mt)
#pragma unroll
        for (int i = 0; i < 16; ++i) O[m][mt][i] *= alpha;
#pragma unroll
      for (int s = 0; s < 2; ++s) {
        uint4 pk;
        pk.x = pack2(S[8 * s + 0], S[8 * s + 1]);
        pk.y = pack2(S[8 * s + 2], S[8 * s + 3]);
        pk.z = pack2(S[8 * s + 4], S[8 * s + 5]);
        pk.w = pack2(S[8 * s + 6], S[8 * s + 7]);
        bf16x8 pf = __builtin_bit_cast(bf16x8, pk);
        O[m][0] = MFMA32(vf[0][s], pf, O[m][0]);
        O[m][1] = MFMA32(vf[1][s], pf, O[m][1]);
      }
    }
  }
  ls[0] += __shfl_xor(ls[0], 32);
  ls[1] += __shfl_xor(ls[1], 32);
  const float inv0 = 1.f / ls[0], inv1 = lam / ls[1];
  float ss = 0.f;
#pragma unroll
  for (int mt = 0; mt < 2; ++mt)
#pragma unroll
    for (int i = 0; i < 16; ++i) {
      float o = O[0][mt][i] * inv0 - O[1][mt][i] * inv1;
      O[0][mt][i] = o;
      ss += o * o;
    }
  ss += __shfl_xor(ss, 32);
  const float rstd = rsqrtf(ss * (1.f / 64.f) + 1e-6f) * (1.f - lam_init);
  const float* sg = opaque(p.in[I_DSUB] + l * 64);
  bf16_t* cat = (bf16_t*)(p.ws + WS_CAT) + tok * D + 768 + h * 64;
#pragma unroll
  for (int mt = 0; mt < 2; ++mt)
#pragma unroll
    for (int g4 = 0; g4 < 4; ++g4) {
      int e0 = mt * 32 + 8 * g4 + 4 * hf;
      uint2 o;
      o.x = pack2(O[0][mt][4 * g4 + 0] * rstd * sg[e0 + 0], O[0][mt][4 * g4 + 1] * rstd * sg[e0 + 1]);
      o.y = pack2(O[0][mt][4 * g4 + 2] * rstd * sg[e0 + 2], O[0][mt][4 * g4 + 3] * rstd * sg[e0 + 3]);
      *(uint2*)(cat + e0) = o;
    }
}

DI void stage_mix(const Params& p, int sid, int l, char* smem) {
  const int NSEQ = sid ? 2 : 32;
  const int T = sid ? 4096 : 256;
  const int NQ = sid ? 4 : 1;
  const int nscan1 = NSEQ * 4 * 2 * NQ;
  const int nattn = NSEQ * 4 * (T / 128);
#define SCAN_LOOP(MIXI, BASE)                                                                 \
  for (int task = first_task(BASE); task < (BASE) + nscan1; task += gridDim.x) {             \
    int u = task - (BASE);                                                                    \
    int q = u % NQ, v_ = u / NQ;                                                              \
    int dir = v_ & 1, h = (v_ >> 1) & 3, seq = v_ >> 3;                                       \
    if (sid) scan_task<MIXI, 4>(p, sid, l, seq, h, dir, q, (float*)smem);                     \
    else scan_task<MIXI, 8>(p, sid, l, seq, h, dir, q, (float*)smem);                         \
  }
  SCAN_LOOP(0, 0)
  SCAN_LOOP(1, nscan1)
  SCAN_LOOP(2, 2 * nscan1)
#undef SCAN_LOOP
  for (int task = first_task(3 * nscan1); task < 3 * nscan1 + nattn; task += gridDim.x) {
    int u = task - 3 * nscan1;
    int nqb = T / 128;
    int qb = u % nqb, h = (u / nqb) & 3, seq = u / (nqb * 4);
    attn_task(p, sid, l, seq, h, qb);
  }
  if (sid) {
    const int nlong = 3 * nscan1;
    if ((int)gridDim.x > nlong + 64) {
      if ((int)blockIdx.x >= nlong) stage_g1(p, 0, l, smem, (int)blockIdx.x - nlong, (int)gridDim.x - nlong);
    } else {
      stage_g1(p, 0, l, smem, (int)blockIdx.x, (int)gridDim.x);
    }
  }
}

DI float4 ld_h4(const h16* q) {
  uint2 u = *(const uint2*)q;
  typedef _Float16 h4 __attribute__((ext_vector_type(4)));
  h4 v = __builtin_bit_cast(h4, u);
  return make_float4((float)v[0], (float)v[1], (float)v[2], (float)v[3]);
}
DI float4 ld_bf4(const bf16_t* q) {
  uint2 u = *(const uint2*)q;
  return make_float4(__uint_as_float(u.x << 16), __uint_as_float(u.x & 0xffff0000u), __uint_as_float(u.y << 16),
                     __uint_as_float(u.y & 0xffff0000u));
}
DI void st_bf4(bf16_t* q, float a, float b, float c, float d) {
  uint2 o;
  o.x = pack2(a, b);
  o.y = pack2(c, d);
  *(uint2*)q = o;
}
DI float4 f4add(float4 a, float4 b) { return make_float4(a.x + b.x, a.y + b.y, a.z + b.z, a.w + b.w); }

DI void stage_post(const Params& p, int sid, int l, char* smem) {
  const int tid = tidx(), wv = tid >> 6, lane = tid & 63;
  const int c0 = lane * 4, head = lane >> 4;
  const float* Y = (const float*)(p.ws + WS_Y);
  const bf16_t* QGZ = wsbf(p, WS_QGZ);
  const h16* RG = (const h16*)(p.ws + WS_RG);
  const h16* BON = (const h16*)(p.ws + WS_BONUS);
  const h16* FSSD = (const h16*)(p.ws + WS_FEED_SSD);
  bf16_t* cat = (bf16_t*)(p.ws + WS_CAT);
  const float4 lng = *(const float4*)(p.in[I_LNG] + l * 256 + c0), lnb = *(const float4*)(p.in[I_LNB] + l * 256 + c0);
  const float4 retg = *(const float4*)(p.in[I_RETG] + l * 256 + c0);
  const float4 sng = *(const float4*)(p.in[I_SNG] + l * 256 + c0);
  const float sd = p.in[I_SD][l * 4 + head];
  const size_t YS = (size_t)NT * 256;
#pragma unroll 2
  for (int tok = blockIdx.x * 4 + wv; tok < NT; tok += gridDim.x * 4) {
    const size_t tb = (size_t)tok * 256 + c0;
    {
      float4 y = f4add(*(const float4*)(Y + tb), *(const float4*)(Y + YS + tb));
      float mu = row_sum16((y.x + y.y) + (y.z + y.w)) * (1.f / 64.f);
      float d0 = y.x - mu, d1 = y.y - mu, d2 = y.z - mu, d3 = y.w - mu;
      float var = row_sum16((d0 * d0 + d1 * d1) + (d2 * d2 + d3 * d3)) * (1.f / 64.f);
      float rs = rsqrtf(var + 64e-5f);
      float4 bo = ld_h4(BON + tb), g = ld_h4(RG + tb);
      st_bf4(cat + (size_t)tok * D + c0, (d0 * rs * lng.x + lnb.x + bo.x) * g.x, (d1 * rs * lng.y + lnb.y + bo.y) * g.y,
             (d2 * rs * lng.z + lnb.z + bo.z) * g.z, (d3 * rs * lng.w + lnb.w + bo.w) * g.w);
    }
    {
      float4 y = f4add(*(const float4*)(Y + 2 * YS + tb), *(const float4*)(Y + 3 * YS + tb));
      float ms = row_sum16((y.x * y.x + y.y * y.y) + (y.z * y.z + y.w * y.w)) * (1.f / 64.f);
      float rs = rsqrtf(ms + 1e-6f);
      float4 g = ld_bf4(QGZ + (size_t)tok * 768 + 256 + c0);
      st_bf4(cat + (size_t)tok * D + 256 + c0, silu_f(g.x) * y.x * rs * retg.x, silu_f(g.y) * y.y * rs * retg.y,
             silu_f(g.z) * y.z * rs * retg.z, silu_f(g.w) * y.w * rs * retg.w);
    }
    {
      float4 y = f4add(*(const float4*)(Y + 4 * YS + tb), *(const float4*)(Y + 5 * YS + tb));
      float4 x = ld_h4(FSSD + (size_t)tok * 512 + 256 + c0);
      float4 z = ld_bf4(QGZ + (size_t)tok * 768 + 512 + c0);
      float y0 = (y.x + x.x * sd) * silu_f(z.x), y1 = (y.y + x.y * sd) * silu_f(z.y);
      float y2 = (y.z + x.z * sd) * silu_f(z.z), y3 = (y.w + x.w * sd) * silu_f(z.w);
      float ms = wave_sum((y0 * y0 + y1 * y1) + (y2 * y2 + y3 * y3)) * (1.f / 256.f);
      float rs = rsqrtf(ms + 1e-6f);
      st_bf4(cat + (size_t)tok * D + 512 + c0, y0 * rs * sng.x, y1 * rs * sng.y, y2 * rs * sng.z, y3 * rs * sng.w);
    }
  }
}

#define XB_TMO      128
#define XB_XCNT(j)  (256  + 64 * (j))
#define XB_XSUB(j)  (1280 + 64 * (j))
#define XB_XGEN(j)  (2304 + 64 * (j))
#define XB_TOP      3328
#define XB_TOPGEN   3392
#define XCD_BAR_WORDS 3456
#define XB_SPIN_CAP (1u << 22)
#define LAS __attribute__((address_space(3)))
DI unsigned xb_ld(unsigned* p) { return __hip_atomic_load(p, __ATOMIC_RELAXED, __HIP_MEMORY_SCOPE_AGENT); }
DI unsigned xb_add(unsigned* p, unsigned v) { return __hip_atomic_fetch_add(p, v, __ATOMIC_RELAXED, __HIP_MEMORY_SCOPE_AGENT); }
DI unsigned xb_xcc_id() { return (unsigned)__builtin_amdgcn_s_getreg((3 << 11) | 20) & 0xFu; }
#define XB_SPIN(cond, bar) do { unsigned _sp = 0; while (cond) { __builtin_amdgcn_s_sleep(1); \
    if ((++_sp & 255u) == 0u) { if (xb_ld(&(bar)[XB_TMO])) break; if (_sp > XB_SPIN_CAP) { atomicAdd(&(bar)[XB_TMO], 1u); break; } } } } while (0)
struct XcdBarrier { unsigned* bar; unsigned x; volatile LAS unsigned* st; };
DI XcdBarrier xcd_barrier_post(unsigned* bar, volatile LAS unsigned* st) {
  XcdBarrier b; b.bar = bar; b.x = xb_xcc_id(); b.st = st;
  if (threadIdx.x == 0) (void)xb_add(&bar[XB_XCNT(b.x)], 1u);
  return b;
}
DI void xcd_barrier_complete(unsigned* bar, unsigned x, unsigned& nloc, unsigned& nx) {
  const unsigned G = gridDim.x * gridDim.y * gridDim.z;
  unsigned sum, cnt, mine, sp = 0u;
  for (;;) {
    sum = 0u; cnt = 0u; mine = 0u;
#pragma unroll
    for (unsigned j = 0; j < 16; ++j) { const unsigned c = xb_ld(&bar[XB_XCNT(j)]); sum += c; cnt += (c > 0u) ? 1u : 0u; mine = (j == x) ? c : mine; }
    if (sum == G) break;
    __builtin_amdgcn_s_sleep(1);
    if ((++sp & 255u) == 0u) { if (xb_ld(&bar[XB_TMO])) break; if (sp > XB_SPIN_CAP) { atomicAdd(&bar[XB_TMO], 1u); break; } }
  }
  nloc = mine > 0u ? mine : 1u; nx = cnt > 0u ? cnt : 1u;
}
DI void xcd_barrier(const XcdBarrier& b) {
  asm volatile("s_waitcnt vmcnt(0)" ::: "memory");
  __syncthreads();
  if (threadIdx.x == 0) {
    unsigned* bar = b.bar;
    __builtin_amdgcn_s_waitcnt(0);
    unsigned nloc = b.st[0], nx = b.st[1];
    if (nloc == 0u) { xcd_barrier_complete(bar, b.x, nloc, nx); b.st[0] = nloc; b.st[1] = nx; }
    const unsigned old = xb_add(&bar[XB_XSUB(b.x)], 1u);
    const unsigned gen = old / nloc;
    if (old + 1u == (gen + 1u) * nloc) {
      __builtin_amdgcn_fence(__ATOMIC_RELEASE, "agent");
      asm volatile("s_waitcnt vmcnt(0)" ::: "memory");
      const unsigned og = xb_add(&bar[XB_TOP], 1u);
      const unsigned tg = og / nx;
      if (og + 1u == (tg + 1u) * nx) xb_add(&bar[XB_TOPGEN], 1u);
      else XB_SPIN(xb_ld(&bar[XB_TOPGEN]) == tg, bar);
      __builtin_amdgcn_fence(__ATOMIC_ACQUIRE, "agent");
      xb_add(&bar[XB_XGEN(b.x)], 1u);
      asm volatile("s_waitcnt vmcnt(0)" ::: "memory");
    } else {
      XB_SPIN(xb_ld(&bar[XB_XGEN(b.x)]) == gen, bar);
      __builtin_amdgcn_fence(__ATOMIC_ACQUIRE, "agent");
      asm volatile("s_waitcnt vmcnt(0)" ::: "memory");
    }
  }
  __syncthreads();
}

DI void run_phase(const Params& p, int ph, char* smem) {
  if (ph == 0) {
    stage0(p, smem);
    if ((int)gridDim.x >= 384) {
      if ((int)blockIdx.x >= 192) stage_w(p, 0, smem, (int)blockIdx.x - 192, (int)gridDim.x - 192);
    } else {
      stage_w(p, 0, smem, (int)blockIdx.x, (int)gridDim.x);
    }
    return;
  }
  if (ph == NPHASE - 1) { stage_final(p); return; }
  int qq = ph - 1;
  int l = qq / 18, k = qq % 18;
  switch (k) {
    case 0:
      if (l > 0) stage_w(p, l, smem, (int)blockIdx.x, (int)gridDim.x);
      stage_norm(p, 1, l, 0);
      break;
    case 1: stage_g1(p, 1, l, smem, (int)blockIdx.x, (int)gridDim.x); break;
    case 2:
      stage_prep(p, 1, l, smem);
      stage_norm(p, 0, l, 0);
      break;
    case 3: stage_mix(p, 1, l, smem); break;
    case 4: stage_post(p, 1, l, smem); break;
    case 5: stage_g2(p, 1, l, smem); break;
    case 6: stage_norm(p, 1, l, 1); break;
    case 7: stage_g3(p, smem); break;
    case 8: stage_conv(p, 1, l); break;
    case 9: stage_g4(p, 1, l, smem); break;
    case 10: stage_prep(p, 0, l, smem); break;
    case 11: stage_mix(p, 0, l, smem); break;
    case 12: stage_post(p, 0, l, smem); break;
    case 13: stage_g2(p, 0, l, smem); break;
    case 14: stage_norm(p, 0, l, 1); break;
    case 15: stage_g3(p, smem); break;
    case 16: stage_conv(p, 0, l); break;
    case 17: stage_g4(p, 0, l, smem); break;
  }
}

#if COOP
__global__ void __launch_bounds__(256, 2) mega_kernel(Params p) {
  __shared__ __attribute__((aligned(16))) char smem[SMEM_BYTES];
  __shared__ uint4 xb_words;
  if (threadIdx.x == 0) xb_words = make_uint4(0u, 0u, 0u, 0u);
  __syncthreads();
  XcdBarrier xb = xcd_barrier_post((unsigned*)(p.ws + WS_BAR), (volatile LAS unsigned*)&xb_words);
  if (p.ws == nullptr) cg::this_grid().sync();
  for (int ph = 0; ph < NPHASE; ++ph) {
    run_phase(p, ph, smem);
    if (ph + 1 < NPHASE) xcd_barrier(xb);
  }
}
#else
__global__ void __launch_bounds__(256, 2) phase_kernel(Params p, int ph) {
  __shared__ __attribute__((aligned(16))) char smem[SMEM_BYTES];
  run_phase(p, ph, smem);
}
#endif

extern "C" void kernel_launch(void* const* d_in, const int* in_sizes, int n_in, void* d_out, int out_size, void* d_ws,
                              size_t ws_size, hipStream_t stream) {
  Params p{};
  for (int i = 0; i < 40; ++i) p.in[i] = (const float*)d_in[i];
  p.out = (float*)d_out;
  p.ws = (char*)d_ws;
  static int grid_blocks = 0;
  if (!grid_blocks) {
    int dev = 0, cus = 0, per_cu = 0;
    hipGetDevice(&dev);
    hipDeviceGetAttribute(&cus, hipDeviceAttributeMultiprocessorCount, dev);
#if COOP
    hipOccupancyMaxActiveBlocksPerMultiprocessor(&per_cu, mega_kernel, 256, 0);
#else
    hipOccupancyMaxActiveBlocksPerMultiprocessor(&per_cu, phase_kernel, 256, 0);
#endif
    if (per_cu < 1) per_cu = 1;
    if (per_cu > 3) per_cu = 3;
    if (cus < 1) cus = 256;
    grid_blocks = cus * per_cu;
  }
#if COOP
  hipMemsetAsync((char*)d_ws + WS_BAR, 0, 16384, stream);
  void* args[] = {&p};
  hipError_t e = hipLaunchCooperativeKernel((void*)mega_kernel, dim3(grid_blocks), dim3(256), args, 0, stream);
  if (e != hipSuccess) fprintf(stderr, "cooperative launch failed: %s (grid %d)\n", hipGetErrorString(e), grid_blocks);
#else
  for (int ph = 0; ph < NPHASE; ++ph) phase_kernel<<<grid_blocks, 256, 0, stream>>>(p, ph);
#endif
}
```

```cpp
#include <hip/hip_runtime.h>
#include <hip/hip_cooperative_groups.h>
#include <cstdio>
namespace cg = cooperative_groups;

#ifndef COOP
#define COOP 1
#endif
#ifndef PROBE_MASK
#define PROBE_MASK 0
#endif

#define DI __device__ __forceinline__
typedef unsigned short bf16_t;
typedef _Float16 h16;
using bf16x8 = __attribute__((ext_vector_type(8))) short;
using h16x8 = __attribute__((ext_vector_type(8))) _Float16;
using f32x16 = __attribute__((ext_vector_type(16))) float;
typedef float v4f_t __attribute__((ext_vector_type(4)));
typedef float v2f_t __attribute__((ext_vector_type(2)));
#define MFMA32(a, b, c) __builtin_amdgcn_mfma_f32_32x32x16_bf16((a), (b), (c), 0, 0, 0)

constexpr int D = 1024, PIN = 3528, PINP = 3584, FF = 2816, FF2 = 5632, NT = 8192;
constexpr int OA = 0, OB = 960, OC = 1984, OD = 2760;
constexpr int NPHASE = 38;

enum { I_XP = 0, I_XS, I_SRW, I_SRET, I_SSSD, I_CK, I_CV, I_C, I_CCTX, I_N1G, I_N2G, I_WMOD, I_BMOD, I_WIN, I_WOUT,
       I_MU, I_W0, I_WUP, I_A0, I_AUP, I_GUP, I_KK, I_KA, I_RK, I_LNG, I_LNB, I_RETG, I_SCW, I_SCB, I_DTB, I_ALOG,
       I_SD, I_SNG, I_DLAM, I_DSUB, I_FUP, I_FCW, I_FCB, I_FDN, I_NFG };

constexpr size_t O_YP = 0, O_YS = 8388608, O_SRW = 16777216, O_SRET = 18874368, O_SSSD = 20971520,
                 O_CK = 23068672, O_CV = 27262976;

constexpr size_t WS_WIN = 0;
constexpr size_t WS_WOUT = WS_WIN + (size_t)PINP * D * 2;
constexpr size_t WS_WUP = WS_WOUT + (size_t)D * D * 2;
constexpr size_t WS_WDN = WS_WUP + (size_t)FF2 * D * 2;
constexpr size_t WS_MOD = WS_WDN + (size_t)D * FF * 2;
constexpr size_t WS_ROPE_RET = WS_MOD + (size_t)2 * 3 * 6144 * 4;
constexpr size_t WS_ROPE_DIF = WS_ROPE_RET + (size_t)2 * 4096 * 32 * 4;
constexpr size_t WS_HBUF = WS_ROPE_DIF + (size_t)2 * 4096 * 16 * 4;
constexpr size_t WS_CAT = WS_HBUF + (size_t)NT * D * 2;
constexpr size_t WS_F = WS_CAT + (size_t)NT * D * 2;
constexpr size_t WS_FEED_RW = WS_F + (size_t)NT * PIN * 2;
constexpr size_t WS_FEED_RET = WS_FEED_RW + (size_t)NT * 2304 * 2;
constexpr size_t WS_FEED_SSD = WS_FEED_RET + (size_t)NT * 768 * 2;
constexpr size_t WS_DTG = WS_FEED_SSD + (size_t)NT * 512 * 2;
constexpr size_t WS_RG = WS_DTG + (size_t)NT * 16 * 4;
constexpr size_t WS_BONUS = WS_RG + (size_t)NT * 256 * 2;
constexpr size_t WS_Y = WS_BONUS + (size_t)NT * 256 * 2;
constexpr size_t WS_KR = WS_Y + (size_t)6 * NT * 256 * 4;
constexpr size_t WS_VT = WS_KR + (size_t)2 * 4 * 2 * 4608 * 32 * 2;
constexpr size_t WS_END = WS_VT + (size_t)2 * 4 * 64 * 4608 * 2;
constexpr size_t WS_QGZ = WS_END;
constexpr size_t WS_BAR = WS_QGZ + (size_t)NT * 768 * 2;
constexpr size_t WS_END2 = WS_BAR + 16384;
constexpr size_t WS_U = WS_FEED_RW;
constexpr size_t WS_ACT = WS_U + (size_t)NT * FF2 * 2;
static_assert(WS_ACT + (size_t)NT * FF * 2 <= WS_BAR, "ACT alias");
static_assert(WS_END2 <= (size_t)256 * 1024 * 1024, "ws");

constexpr int SMEM_BYTES = 49664;
constexpr int TC = 16;
constexpr int SST = 388;
constexpr int SBUF = TC * SST;

struct Params {
  const float* in[40];
  float* out;
  char* ws;
};

typedef float f32x2_t __attribute__((ext_vector_type(2)));
typedef __bf16 bf16x2_t __attribute__((ext_vector_type(2)));
DI unsigned pack2(float a, float b) {
  f32x2_t v;
  v.x = a;
  v.y = b;
  return __builtin_bit_cast(unsigned, __builtin_convertvector(v, bf16x2_t));
}
DI bf16_t f2bf(float x) { return (bf16_t)(pack2(x, 0.f) & 0xffffu); }
DI float bf2f(bf16_t b) { return __uint_as_float(((unsigned)b) << 16); }
DI float fexp(float x) { return __expf(x); }
DI float frcp(float x) { return __builtin_amdgcn_rcpf(x); }
DI float silu_f(float x) { return x * frcp(1.f + fexp(-x)); }
DI float sigmoid_f(float x) { return frcp(1.f + fexp(-x)); }
DI float softplus_f(float x) { return fmaxf(x, 0.f) + __logf(1.f + fexp(-fabsf(x))); }
DI float tanh_f(float x) { return 1.f - 2.f * frcp(fexp(2.f * x) + 1.f); }
DI float wave_sum(float v) {
#pragma unroll
  for (int o = 32; o > 0; o >>= 1) v += __shfl_xor(v, o);
  return v;
}
DI float dpp_ror(float v, int) { return v; }
DI float row_sum16(float v) {
  v += __builtin_bit_cast(float, __builtin_amdgcn_update_dpp(0, __builtin_bit_cast(int, v), 0x128, 0xf, 0xf, false));
  v += __builtin_bit_cast(float, __builtin_amdgcn_update_dpp(0, __builtin_bit_cast(int, v), 0x124, 0xf, 0xf, false));
  v += __builtin_bit_cast(float, __builtin_amdgcn_update_dpp(0, __builtin_bit_cast(int, v), 0x122, 0xf, 0xf, false));
  v += __builtin_bit_cast(float, __builtin_amdgcn_update_dpp(0, __builtin_bit_cast(int, v), 0x121, 0xf, 0xf, false));
  return v;
}
DI int tidx() {
  int t = (int)__builtin_amdgcn_workitem_id_x();
  asm volatile("" : "+v"(t));
  return t;
}
template <class T>
DI T* opaque(T* q) {
  asm volatile("" : "+s"(q));
  return q;
}
DI void lds_barrier() { asm volatile("s_waitcnt lgkmcnt(0)\n\ts_barrier" ::: "memory"); }
DI int crow(int i, int hf) { return (i & 3) + 8 * (i >> 2) + 4 * hf; }

DI const bf16_t* wsbf(const Params& p, size_t off) { return (const bf16_t*)(p.ws + off); }

DI void stage0(const Params& p, char* smem) {
  float* sil = (float*)smem;
  float* red = sil + 3072;
  const int tid = tidx(), lane = tid & 63, wv = tid >> 6;
  float* MOD = (float*)(p.ws + WS_MOD);
  for (int i = tid; i < 3072; i += 256) {
    int c = i >> 10, k = i & 1023;
    float v = (c == 0) ? p.in[I_CCTX][k] : p.in[I_C][(c - 1) * 1024 + k];
    sil[i] = silu_f(v);
  }
  __syncthreads();
  for (int task = blockIdx.x; task < 192; task += gridDim.x) {
    int l = task / 96, j0 = (task % 96) * 64;
    const float* wm = p.in[I_WMOD] + (size_t)l * 1024 * 6144 + j0 + lane;
    float a0 = 0.f, a1 = 0.f, a2 = 0.f;
    int kb = wv * 256;
#pragma unroll 8
    for (int k = 0; k < 256; ++k) {
      float w = wm[(size_t)(kb + k) * 6144];
      a0 += sil[kb + k] * w;
      a1 += sil[1024 + kb + k] * w;
      a2 += sil[2048 + kb + k] * w;
    }
    red[(wv * 3 + 0) * 64 + lane] = a0;
    red[(wv * 3 + 1) * 64 + lane] = a1;
    red[(wv * 3 + 2) * 64 + lane] = a2;
    __syncthreads();
    if (tid < 192) {
      int c = tid >> 6, j = tid & 63;
      float s = red[(0 * 3 + c) * 64 + j] + red[(1 * 3 + c) * 64 + j] + red[(2 * 3 + c) * 64 + j] + red[(3 * 3 + c) * 64 + j];
      MOD[(size_t)(l * 3 + c) * 6144 + j0 + j] = s + p.in[I_BMOD][l * 6144 + j0 + j];
    }
    __syncthreads();
  }
  float* rc = (float*)(p.ws + WS_ROPE_RET);
  float* rs = rc + 4096 * 32;
  float* dc = (float*)(p.ws + WS_ROPE_DIF);
  float* ds = dc + 4096 * 16;
  const int gt = blockIdx.x * 256 + tid, gs = gridDim.x * 256;
  for (int i = gt; i < 4096 * 32; i += gs) {
    int t = i >> 5, j = i & 31;
    float pos = (j < 16) ? (float)(t >> 6) : (float)(t & 63);
    float fr = powf(10000.f, -(float)(j & 15) / 16.f);
    float ang = pos * fr;
    rc[i] = cosf(ang);
    rs[i] = sinf(ang);
  }
  for (int i = gt; i < 4096 * 16; i += gs) {
    int t = i >> 4, j = i & 15;
    float pos = (j < 8) ? (float)(t >> 6) : (float)(t & 63);
    float fr = powf(10000.f, -(float)(j & 7) / 8.f);
    float ang = pos * fr;
    dc[i] = cosf(ang);
    ds[i] = sinf(ang);
  }
}

DI void transpose_tile(const float* __restrict__ src, int K, int N, bf16_t* __restrict__ dst, int kt, int nt, float* tile) {
  const int tid = tidx();
  const int k0 = kt * 64, n0 = nt * 64;
  {
    int nl = tid & 63, ks = tid >> 6;
#pragma unroll 4
    for (int i = 0; i < 16; ++i) {
      int kl = i * 4 + ks;
      int n = n0 + nl;
      tile[kl * 65 + nl] = (n < N) ? src[(size_t)(k0 + kl) * N + n] : 0.f;
    }
  }
  __syncthreads();
  {
    int kl = tid & 63, ns = tid >> 6;
#pragma unroll 4
    for (int i = 0; i < 16; ++i) {
      int nl = i * 4 + ns;
      dst[(size_t)(n0 + nl) * K + k0 + kl] = f2bf(tile[kl * 65 + nl]);
    }
  }
  __syncthreads();
}

DI void stage_w(const Params& p, int l, char* smem, int tstart, int tstride) {
  float* tile = (float*)smem;
  constexpr int T_IN = 16 * 56, T_OUT = 16 * 16, T_UP = 16 * 88, T_DN = 44 * 16;
  for (int task = tstart; task < T_IN + T_OUT + T_UP + T_DN; task += tstride) {
    int t = task;
    if (t < T_IN) {
      transpose_tile(p.in[I_WIN] + (size_t)l * D * PIN, D, PIN, (bf16_t*)(p.ws + WS_WIN), t % 16, t / 16, tile);
    } else if ((t -= T_IN) < T_OUT) {
      transpose_tile(p.in[I_WOUT] + (size_t)l * D * D, D, D, (bf16_t*)(p.ws + WS_WOUT), t % 16, t / 16, tile);
    } else if ((t -= T_OUT) < T_UP) {
      transpose_tile(p.in[I_FUP] + (size_t)l * D * FF2, D, FF2, (bf16_t*)(p.ws + WS_WUP), t % 16, t / 16, tile);
    } else {
      t -= T_UP;
      transpose_tile(p.in[I_FDN] + (size_t)l * FF * D, FF, D, (bf16_t*)(p.ws + WS_WDN), t % 44, t / 44, tile);
    }
  }
}

DI void stage_norm(const Params& p, int sid, int l, int which) {
  const int T = sid ? 4096 : 256;
  const int lane = tidx() & 63, wv = tidx() >> 6;
  const float* xin = (which == 0 && l == 0) ? p.in[sid ? I_XS : I_XP] : (p.out + (sid ? O_YS : O_YP));
  const float* g = p.in[which ? I_N2G : I_N1G] + l * D;
  const float* MOD = (const float*)(p.ws + WS_MOD);
  bf16_t* hb = (bf16_t*)(p.ws + WS_HBUF);
  for (int grp = blockIdx.x * 4 + wv; grp < NT / 4; grp += gridDim.x * 4) {
    const int tok0 = grp * 4;
    const int cond = sid ? 1 + tok0 / T : 0;
    const float* md = MOD + (size_t)(l * 3 + cond) * 6144 + which * 3072;
    float4 gs[4], sh[4];
#pragma unroll
    for (int i = 0; i < 4; ++i) {
      const int c = i * 256 + lane * 4;
      const float4 gg = *(const float4*)(g + c);
      const float4 sc = *(const float4*)(md + 1024 + c);
      sh[i] = *(const float4*)(md + c);
      gs[i] = make_float4(gg.x * (1.f + sc.x), gg.y * (1.f + sc.y), gg.z * (1.f + sc.z), gg.w * (1.f + sc.w));
    }
    float4 v[4][4];
#pragma unroll
    for (int k = 0; k < 4; ++k)
#pragma unroll
      for (int i = 0; i < 4; ++i) v[k][i] = *(const float4*)(xin + (size_t)(tok0 + k) * D + i * 256 + lane * 4);
#pragma unroll
    for (int k = 0; k < 4; ++k) {
      float ss = 0.f;
#pragma unroll
      for (int i = 0; i < 4; ++i) ss += v[k][i].x * v[k][i].x + v[k][i].y * v[k][i].y + v[k][i].z * v[k][i].z + v[k][i].w * v[k][i].w;
      ss = wave_sum(ss);
      const float rstd = rsqrtf(ss * (1.f / 1024.f) + 1e-6f);
#pragma unroll
      for (int i = 0; i < 4; ++i) {
        const int c = i * 256 + lane * 4;
        uint2 pk;
        pk.x = pack2(v[k][i].x * rstd * gs[i].x + sh[i].x, v[k][i].y * rstd * gs[i].y + sh[i].y);
        pk.y = pack2(v[k][i].z * rstd * gs[i].z + sh[i].z, v[k][i].w * rstd * gs[i].w + sh[i].w);
        *(uint2*)(hb + (size_t)(tok0 + k) * D + c) = pk;
      }
    }
  }
}

DI void stage_final(const Params& p) {
  const int lane = tidx() & 63, wv = tidx() >> 6;
  const float* g = p.in[I_NFG];
  float4 gf[4];
#pragma unroll
  for (int i = 0; i < 4; ++i) gf[i] = *(const float4*)(g + i * 256 + lane * 4);
#pragma unroll 2
  for (int tok = blockIdx.x * 4 + wv; tok < 2 * NT; tok += gridDim.x * 4) {
    float* xr = p.out + (size_t)tok * D;
    float4 v[4];
    float ss = 0.f;
#pragma unroll
    for (int i = 0; i < 4; ++i) {
      v[i] = *(const float4*)(xr + i * 256 + lane * 4);
      ss += v[i].x * v[i].x + v[i].y * v[i].y + v[i].z * v[i].z + v[i].w * v[i].w;
    }
    ss = wave_sum(ss);
    float rstd = rsqrtf(ss * (1.f / 1024.f) + 1e-6f);
#pragma unroll
    for (int i = 0; i < 4; ++i) {
      int c = i * 256 + lane * 4;
      float4 gg = gf[i];
      float4 o;
      o.x = v[i].x * rstd * gg.x;
      o.y = v[i].y * rstd * gg.y;
      o.z = v[i].z * rstd * gg.z;
      o.w = v[i].w * rstd * gg.w;
      *(float4*)(xr + c) = o;
    }
  }
}

DI int first_task(int base) {
  int g = (int)gridDim.x;
  int d = ((int)blockIdx.x - base) % g;
  if (d < 0) d += g;
  return base + d;
}

template <class Epi>
DI void gemm_tile_128(const bf16_t* __restrict__ A, int lda, const bf16_t* __restrict__ Bt, int ldb, int K, int m0, int n0,
                      char* smem, Epi epi) {
  bf16_t* sA = (bf16_t*)smem;
  bf16_t* sB = sA + 2 * 5120;
  const int tid = tidx(), lane = tid & 63, wid = tid >> 6, wm = wid >> 1, wn = wid & 1;
  const int r = lane & 31, hf = lane >> 5;
  f32x16 acc[2][2];
#pragma unroll
  for (int a = 0; a < 2; ++a)
#pragma unroll
    for (int b = 0; b < 2; ++b)
#pragma unroll
      for (int i = 0; i < 16; ++i) acc[a][b][i] = 0.f;
  const int lrow = tid >> 2, lkc = tid & 3;
  const bf16_t* ga = A + (size_t)(m0 + lrow) * lda + lkc * 8;
  const bf16_t* gb = Bt + (size_t)(n0 + lrow) * ldb + lkc * 8;
  const size_t a64 = (size_t)64 * lda, b64 = (size_t)64 * ldb;
  const int so = lrow * 40 + lkc * 8;
  uint4 ra0_0, ra1_0, rb0_0, rb1_0, ra0_1, ra1_1, rb0_1, rb1_1, ra0_2, ra1_2, rb0_2, rb1_2, ra0_3, ra1_3, rb0_3, rb1_3;
#define GL(n, kk)                                   \
  {                                                 \
    ra0_##n = *(const uint4*)(ga + (kk));           \
    ra1_##n = *(const uint4*)(ga + a64 + (kk));     \
    rb0_##n = *(const uint4*)(gb + (kk));           \
    rb1_##n = *(const uint4*)(gb + b64 + (kk));     \
  }
#define ST(n, buf)                                            \
  {                                                           \
    *(uint4*)(sA + (buf) * 5120 + so) = ra0_##n;              \
    *(uint4*)(sA + (buf) * 5120 + so + 64 * 40) = ra1_##n;    \
    *(uint4*)(sB + (buf) * 5120 + so) = rb0_##n;              \
    *(uint4*)(sB + (buf) * 5120 + so + 64 * 40) = rb1_##n;    \
  }
#define COMPUTE(buf)                                                          \
  {                                                                           \
    const bf16_t* cA = sA + (buf) * 5120 + (wm * 64 + r) * 40 + hf * 8;       \
    const bf16_t* cB = sB + (buf) * 5120 + (wn * 64 + r) * 40 + hf * 8;       \
    _Pragma("unroll") for (int s = 0; s < 2; ++s) {                           \
      bf16x8 a0 = *(const bf16x8*)(cA + s * 16);                              \
      bf16x8 a1 = *(const bf16x8*)(cA + 32 * 40 + s * 16);                    \
      bf16x8 b0 = *(const bf16x8*)(cB + s * 16);                              \
      bf16x8 b1 = *(const bf16x8*)(cB + 32 * 40 + s * 16);                    \
      acc[0][0] = MFMA32(a0, b0, acc[0][0]);                                  \
      acc[0][1] = MFMA32(a0, b1, acc[0][1]);                                  \
      acc[1][0] = MFMA32(a1, b0, acc[1][0]);                                  \
      acc[1][1] = MFMA32(a1, b1, acc[1][1]);                                  \
    }                                                                         \
  }
  const int KT = K >> 5;
  GL(0, 0) GL(1, 32) GL(2, 64) GL(3, 96)
  ST(0, 0)
  GL(0, 128)
  lds_barrier();
  for (int kt = 0; kt < KT; kt += 4) {
    COMPUTE(0)
    ST(1, 1)
    if (kt + 5 < KT) GL(1, (kt + 5) << 5)
    lds_barrier();
    COMPUTE(1)
    ST(2, 0)
    if (kt + 6 < KT) GL(2, (kt + 6) << 5)
    lds_barrier();
    COMPUTE(0)
    ST(3, 1)
    if (kt + 7 < KT) GL(3, (kt + 7) << 5)
    lds_barrier();
    COMPUTE(1)
    if (kt + 4 < KT) ST(0, 0)
    if (kt + 8 < KT) GL(0, (kt + 8) << 5)
    lds_barrier();
  }
#undef GL
#undef ST
#undef COMPUTE
#pragma unroll
  for (int mt = 0; mt < 2; ++mt)
#pragma unroll
    for (int nt = 0; nt < 2; ++nt) {
#pragma unroll
      for (int i = 0; i < 16; ++i) {
        int row = m0 + wm * 64 + mt * 32 + crow(i, hf);
        int col = n0 + wn * 64 + nt * 32 + r;
        epi(row, col, acc[mt][nt][i]);
      }
      __builtin_amdgcn_sched_barrier(0);
    }
}

DI void stage_g1(const Params& p, int sid, int l, char* smem, int tstart, int tstride) {
  const bf16_t* A = wsbf(p, WS_HBUF);
  const bf16_t* Bt = wsbf(p, WS_WIN);
  bf16_t* F = (bf16_t*)(p.ws + WS_F);
  float* ok = p.out + O_CK;
  float* ov = p.out + O_CV;
  const int MT = NT / 128, NTL = PINP / 128;
  for (int tile = tstart; tile < MT * NTL; tile += tstride) {
    int mt = tile % MT, nt = tile / MT;
    gemm_tile_128(A, D, Bt, D, D, mt * 128, nt * 128, smem, [=](int row, int col, float v) __attribute__((always_inline)) {
      if (col < PIN) {
        F[(size_t)row * PIN + col] = f2bf(v);
        if (sid == 0 && col >= OD + 256) {
          int b = row >> 8, t = row & 255;
          size_t base = ((size_t)(b * 2 + l) * 256 + t) * 256;
          if (col < OD + 512) ok[base + (col - (OD + 256))] = v;
          else ov[base + (col - (OD + 512))] = v;
        }
      }
    });
  }
}

DI void stage_g2(const Params& p, int sid, int l, char* smem) {
  const int T = sid ? 4096 : 256;
  const bf16_t* A = wsbf(p, WS_CAT);
  const bf16_t* Bt = wsbf(p, WS_WOUT);
  const float* xin = (l == 0) ? p.in[sid ? I_XS : I_XP] : (p.out + (sid ? O_YS : O_YP));
  float* xo = p.out + (sid ? O_YS : O_YP);
  const float* MOD = (const float*)(p.ws + WS_MOD);
  const int MT = NT / 128, NTL = D / 128;
  for (int tile = blockIdx.x; tile < MT * NTL; tile += gridDim.x) {
    int mt = tile % MT, nt = tile / MT;
    int cond = sid ? 1 + (mt * 128) / T : 0;
    const float* gate = MOD + (size_t)(l * 3 + cond) * 6144 + 2048;
    gemm_tile_128(A, D, Bt, D, D, mt * 128, nt * 128, smem, [=](int row, int col, float v) __attribute__((always_inline)) {
      size_t idx = (size_t)row * D + col;
      xo[idx] = xin[idx] + gate[col] * v;
    });
  }
}

DI void stage_g3(const Params& p, char* smem) {
  const bf16_t* A = wsbf(p, WS_HBUF);
  const bf16_t* Bt = wsbf(p, WS_WUP);
  bf16_t* U = (bf16_t*)(p.ws + WS_U);
  const int MT = NT / 128, NTL = FF2 / 128;
  for (int tile = blockIdx.x; tile < MT * NTL; tile += gridDim.x) {
    int mt = tile % MT, nt = tile / MT;
    gemm_tile_128(A, D, Bt, D, D, mt * 128, nt * 128, smem,
                  [=](int row, int col, float v) __attribute__((always_inline)) { U[(size_t)row * FF2 + col] = f2bf(v); });
  }
}

DI void stage_g4(const Params& p, int sid, int l, char* smem) {
  const int T = sid ? 4096 : 256;
  const bf16_t* A = wsbf(p, WS_ACT);
  const bf16_t* Bt = wsbf(p, WS_WDN);
  float* xo = p.out + (sid ? O_YS : O_YP);
  const float* MOD = (const float*)(p.ws + WS_MOD);
  const int MT = NT / 128, NTL = D / 128;
  for (int tile = blockIdx.x; tile < MT * NTL; tile += gridDim.x) {
    int mt = tile % MT, nt = tile / MT;
    int cond = sid ? 1 + (mt * 128) / T : 0;
    const float* gate = MOD + (size_t)(l * 3 + cond) * 6144 + 5120;
    gemm_tile_128(A, FF, Bt, FF, FF, mt * 128, nt * 128, smem, [=](int row, int col, float v) __attribute__((always_inline)) {
      size_t idx = (size_t)row * D + col;
      xo[idx] = xo[idx] + gate[col] * v;
    });
  }
}

DI void stage_conv(const Params& p, int sid, int l) {
  const int T = sid ? 4096 : 256;
  const bf16_t* U = wsbf(p, WS_U);
  bf16_t* ACT = (bf16_t*)(p.ws + WS_ACT);
  const float* cw = p.in[I_FCW] + (size_t)l * 3 * FF2;
  const float* cb = p.in[I_FCB] + (size_t)l * FF2;
  const int NG = FF / 8;
  const size_t total = (size_t)(NT / 8) * NG;
  for (size_t i = (size_t)blockIdx.x * 256 + tidx(); i < total; i += (size_t)gridDim.x * 256) {
    const int tq = (int)(i / NG), j0 = (int)(i % NG) * 8;
    const int tok0 = tq * 8;
    const int t = tok0 % T;
    float wg[3][8], wv[3][8];
#pragma unroll
    for (int tap = 0; tap < 3; ++tap) {
      const float* wp = cw + tap * FF2 + j0;
      const float4 a0 = *(const float4*)(wp), a1 = *(const float4*)(wp + 4);
      const float4 b0 = *(const float4*)(wp + FF), b1 = *(const float4*)(wp + FF + 4);
      wg[tap][0] = a0.x; wg[tap][1] = a0.y; wg[tap][2] = a0.z; wg[tap][3] = a0.w;
      wg[tap][4] = a1.x; wg[tap][5] = a1.y; wg[tap][6] = a1.z; wg[tap][7] = a1.w;
      wv[tap][0] = b0.x; wv[tap][1] = b0.y; wv[tap][2] = b0.z; wv[tap][3] = b0.w;
      wv[tap][4] = b1.x; wv[tap][5] = b1.y; wv[tap][6] = b1.z; wv[tap][7] = b1.w;
    }
    float g[8][8], v[8][8];
    {
      const float4 a0 = *(const float4*)(cb + j0), a1 = *(const float4*)(cb + j0 + 4);
      const float4 b0 = *(const float4*)(cb + FF + j0), b1 = *(const float4*)(cb + FF + j0 + 4);
#pragma unroll
      for (int o = 0; o < 8; ++o) {
        g[o][0] = a0.x; g[o][1] = a0.y; g[o][2] = a0.z; g[o][3] = a0.w;
        g[o][4] = a1.x; g[o][5] = a1.y; g[o][6] = a1.z; g[o][7] = a1.w;
        v[o][0] = b0.x; v[o][1] = b0.y; v[o][2] = b0.z; v[o][3] = b0.w;
        v[o][4] = b1.x; v[o][5] = b1.y; v[o][6] = b1.z; v[o][7] = b1.w;
      }
    }
#pragma unroll
    for (int r = -1; r <= 8; ++r) {
      const int tt = t + r;
      if (tt < 0 || tt >= T) continue;
      const bf16_t* ur = U + (size_t)(tok0 + r) * FF2 + j0;
      const bf16x8 ug = *(const bf16x8*)(ur);
      const bf16x8 uv = *(const bf16x8*)(ur + FF);
      float fg[8], fv[8];
#pragma unroll
      for (int e = 0; e < 8; ++e) { fg[e] = bf2f((bf16_t)ug[e]); fv[e] = bf2f((bf16_t)uv[e]); }
#pragma unroll
      for (int o = 0; o < 8; ++o) {
        const int tap = r - o + 1;
        if (tap >= 0 && tap <= 2) {
#pragma unroll
          for (int e = 0; e < 8; ++e) {
            g[o][e] += wg[tap][e] * fg[e];
            v[o][e] += wv[tap][e] * fv[e];
          }
        }
      }
    }
#pragma unroll
    for (int o = 0; o < 8; ++o) {
      uint4 q;
      q.x = pack2(silu_f(g[o][0]) * v[o][0], silu_f(g[o][1]) * v[o][1]);
      q.y = pack2(silu_f(g[o][2]) * v[o][2], silu_f(g[o][3]) * v[o][3]);
      q.z = pack2(silu_f(g[o][4]) * v[o][4], silu_f(g[o][5]) * v[o][5]);
      q.w = pack2(silu_f(g[o][6]) * v[o][6], silu_f(g[o][7]) * v[o][7]);
      *(uint4*)(ACT + (size_t)(tok0 + o) * FF + j0) = q;
    }
  }
}

DI void stage_prep(const Params& p, int sid, int l, char* smem) {
  const int T = sid ? 4096 : 256;
  const int NK = sid ? 4608 : 256;
  float* fs = (float*)smem;
  const int tid = tidx();
  const int c = tid;
  const bf16_t* F = wsbf(p, WS_F);
  h16* FRW = (h16*)(p.ws + WS_FEED_RW);
  h16* FRET = (h16*)(p.ws + WS_FEED_RET);
  h16* FSSD = (h16*)(p.ws + WS_FEED_SSD);
  float* DTG = (float*)(p.ws + WS_DTG);
  h16* RG = (h16*)(p.ws + WS_RG);
  h16* BON = (h16*)(p.ws + WS_BONUS);
  bf16_t* KR = (bf16_t*)(p.ws + WS_KR);
  bf16_t* VT = (bf16_t*)(p.ws + WS_VT);
  bf16_t* QGZ = (bf16_t*)(p.ws + WS_QGZ);
  const float* mu = p.in[I_MU] + l * 960;
  const float* wup = p.in[I_WUP] + (size_t)l * 2 * 32 * 256;
  const float* aup = p.in[I_AUP] + (size_t)l * 2 * 32 * 256;
  const float* gup = p.in[I_GUP] + (size_t)l * 64 * 256;
  const float* rcs = (const float*)(p.ws + WS_ROPE_RET);
  const float* rsn = rcs + 4096 * 32;
  const float* dcs = (const float*)(p.ws + WS_ROPE_DIF);
  const float* dsn = dcs + 4096 * 16;
  const int ntask = NT / 8 + (sid ? 128 : 0);
  for (int task = blockIdx.x; task < ntask; task += gridDim.x) {
    if (task >= NT / 8) {
      int tg = task - NT / 8;
      int b = tg >> 6, p0 = (tg & 63) * 8;
      int hh = c >> 6, m = (c >> 5) & 1, d = c & 31, e = c & 63;
      const float* ck = p.in[I_CK] + ((size_t)(b * 2 + l) * 512 + p0) * 256 + c;
      const float* cv = p.in[I_CV] + ((size_t)(b * 2 + l) * 512 + p0) * 256 + c;
      float vv[8];
#pragma unroll
      for (int tl = 0; tl < 8; ++tl) {
        KR[((size_t)((b * 4 + hh) * 2 + m) * NK + 4096 + p0 + tl) * 32 + d] = f2bf(ck[tl * 256]);
        vv[tl] = cv[tl * 256];
      }
      uint4 o;
      o.x = pack2(vv[0], vv[1]);
      o.y = pack2(vv[2], vv[3]);
      o.z = pack2(vv[4], vv[5]);
      o.w = pack2(vv[6], vv[7]);
      *(uint4*)(VT + ((size_t)(b * 4 + hh) * 64 + e) * NK + 4096 + p0) = o;
      continue;
    }
    const int tok0 = task * 8;
    const int seq = tok0 / T, t0 = tok0 % T;
    if (tid < 240) {
      const int qd = tid / 120, g8 = tid - qd * 120;
      const int cc = g8 * 8;
      const int tb = t0 + qd * 4;
      const bf16_t* fr = F + (size_t)(tok0 + qd * 4) * PIN + cc;
      bf16x8 rows[6];
#pragma unroll
      for (int r = 0; r < 6; ++r) {
        const int tr = tb + r - 1;
        bf16x8 z8 = {0, 0, 0, 0, 0, 0, 0, 0};
        rows[r] = z8;
        if (tr >= 0 && tr < T) rows[r] = *(const bf16x8*)(fr + (long)(r - 1) * PIN);
      }
      const float4 m0 = *(const float4*)(mu + cc), m1 = *(const float4*)(mu + cc + 4);
      const float mm[8] = {m0.x, m0.y, m0.z, m0.w, m1.x, m1.y, m1.z, m1.w};
#pragma unroll
      for (int o4 = 0; o4 < 4; ++o4) {
        float o[8];
#pragma unroll
        for (int e = 0; e < 8; ++e) {
          float c_ = bf2f((bf16_t)rows[o4 + 1][e]);
          float p_ = bf2f((bf16_t)rows[o4][e]);
          float n_ = bf2f((bf16_t)rows[o4 + 2][e]);
          float v = c_ + mm[e] * (0.5f * (p_ + n_) - c_);
          if (cc >= 768 && cc < 832) v = tanh_f(v);
          else if (cc >= 896) v = sigmoid_f(v);
          o[e] = v;
        }
        float* dst = fs + (qd * 4 + o4) * 960 + cc;
        *(float4*)(dst) = make_float4(o[0], o[1], o[2], o[3]);
        *(float4*)(dst + 4) = make_float4(o[4], o[5], o[6], o[7]);
      }
    }
    __syncthreads();
#pragma unroll 1
    for (int hb = 0; hb < 2; ++hb) {
      const float* fsb = fs + hb * 4 * 960;
      float aw0[4], aw1[4], aa0[4], aa1[4], ag[4];
#pragma unroll
      for (int tl = 0; tl < 4; ++tl) { aw0[tl] = 0.f; aw1[tl] = 0.f; aa0[tl] = 0.f; aa1[tl] = 0.f; ag[tl] = 0.f; }
#pragma unroll 8
      for (int rr = 0; rr < 32; ++rr) {
        float wu0 = wup[rr * 256 + c], wu1 = wup[(32 + rr) * 256 + c];
        float au0 = aup[rr * 256 + c], au1 = aup[(32 + rr) * 256 + c];
#pragma unroll
        for (int tl = 0; tl < 4; ++tl) {
          const float* fr = fsb + tl * 960;
          aw0[tl] += fr[768 + rr] * wu0;
          aw1[tl] += fr[800 + rr] * wu1;
          aa0[tl] += fr[832 + rr] * au0;
          aa1[tl] += fr[864 + rr] * au1;
        }
      }
#pragma unroll 16
      for (int jj = 0; jj < 64; ++jj) {
        float gu = gup[jj * 256 + c];
#pragma unroll
        for (int tl = 0; tl < 4; ++tl) ag[tl] += fsb[tl * 960 + 896 + jj] * gu;
      }
      const float w00 = p.in[I_W0][(l * 2 + 0) * 256 + c], w01 = p.in[I_W0][(l * 2 + 1) * 256 + c];
      const float a00 = p.in[I_A0][(l * 2 + 0) * 256 + c], a01 = p.in[I_A0][(l * 2 + 1) * 256 + c];
      const float kkc = p.in[I_KK][l * 256 + c], kac = p.in[I_KA][l * 256 + c], rkc = p.in[I_RK][l * 256 + c];
#pragma unroll
      for (int tl = 0; tl < 4; ++tl) {
        const float* fr = fsb + tl * 960;
        float r = fr[c], k = fr[256 + c], v = fr[512 + c];
        float kkv = k * kkc;
        float ss = wave_sum(kkv * kkv);
        float kkn = kkv * rsqrtf(fmaxf(ss, 1e-12f));
        float bs = wave_sum(r * k * rkc);
        size_t tok = (size_t)(tok0 + hb * 4 + tl);
        h16* o = FRW + tok * 2304 + c;
        o[0] = (h16)r;
        o[256] = (h16)v;
        o[512] = (h16)kkn;
        {
          float x = w00 + aw0[tl];
          float dec = fexp(-fexp(-softplus_f(-x) - 0.5f));
          float a = sigmoid_f(a00 + aa0[tl]);
          o[3 * 256] = (h16)dec;
          o[4 * 256] = (h16)(k * (1.f + (a - 1.f) * kac));
          o[5 * 256] = (h16)(kkn * a);
        }
        {
          float x = w01 + aw1[tl];
          float dec = fexp(-fexp(-softplus_f(-x) - 0.5f));
          float a = sigmoid_f(a01 + aa1[tl]);
          o[6 * 256] = (h16)dec;
          o[7 * 256] = (h16)(k * (1.f + (a - 1.f) * kac));
          o[8 * 256] = (h16)(kkn * a);
        }
        RG[tok * 256 + c] = (h16)ag[tl];
        BON[tok * 256 + c] = (h16)(bs * v);
      }
    }
    {
      const int tl = tid >> 5, c8 = (tid & 31) * 8;
      const size_t tok = (size_t)(tok0 + tl);
      const int t = t0 + tl;
      {
        const bf16_t* fr = F + tok * PIN + OB;
        const int i64 = c8 & 63;
        const int c8p = (i64 < 32) ? c8 + 32 : c8 - 32;
        const bf16x8 q8 = *(const bf16x8*)(fr + c8), k8 = *(const bf16x8*)(fr + 256 + c8), v8 = *(const bf16x8*)(fr + 512 + c8);
        float qf[8], kf[8];
#pragma unroll
        for (int e = 0; e < 8; ++e) { qf[e] = bf2f((bf16_t)q8[e]); kf[e] = bf2f((bf16_t)k8[e]); }
        if (sid) {
          const bf16x8 qp8 = *(const bf16x8*)(fr + c8p), kp8 = *(const bf16x8*)(fr + 256 + c8p);
          const float* cpt = rcs + t * 32 + (i64 & 31);
          const float* spt = rsn + t * 32 + (i64 & 31);
          const float4 ca = *(const float4*)cpt, cb4 = *(const float4*)(cpt + 4);
          const float4 sa4 = *(const float4*)spt, sb4 = *(const float4*)(spt + 4);
          const float cs[8] = {ca.x, ca.y, ca.z, ca.w, cb4.x, cb4.y, cb4.z, cb4.w};
          const float sn[8] = {sa4.x, sa4.y, sa4.z, sa4.w, sb4.x, sb4.y, sb4.z, sb4.w};
#pragma unroll
          for (int e = 0; e < 8; ++e) {
            float qp = bf2f((bf16_t)qp8[e]), kp = bf2f((bf16_t)kp8[e]);
            if (i64 < 32) { qf[e] = qf[e] * cs[e] - qp * sn[e]; kf[e] = kf[e] * cs[e] - kp * sn[e]; }
            else { qf[e] = qf[e] * cs[e] + qp * sn[e]; kf[e] = kf[e] * cs[e] + kp * sn[e]; }
          }
        }
        h16x8 oq, ok_, ov_;
#pragma unroll
        for (int e = 0; e < 8; ++e) { oq[e] = (h16)qf[e]; ok_[e] = (h16)(kf[e] * 0.125f); ov_[e] = (h16)bf2f((bf16_t)v8[e]); }
        h16* o = FRET + tok * 768 + c8;
        *(h16x8*)(o) = oq;
        *(h16x8*)(o + 256) = ok_;
        *(h16x8*)(o + 512) = ov_;
      }
      {
        const bf16_t* fr = F + tok * PIN + OD;
        const int hh = c8 >> 6, m = (c8 >> 5) & 1, d8 = c8 & 31;
        const int c8p = (d8 < 16) ? c8 + 16 : c8 - 16;
        const bf16x8 k8 = *(const bf16x8*)(fr + 256 + c8), q8 = *(const bf16x8*)(fr + c8);
        float kf[8], qf[8];
#pragma unroll
        for (int e = 0; e < 8; ++e) { kf[e] = bf2f((bf16_t)k8[e]); qf[e] = bf2f((bf16_t)q8[e]); }
        if (sid) {
          const bf16x8 kp8 = *(const bf16x8*)(fr + 256 + c8p), qp8 = *(const bf16x8*)(fr + c8p);
          const float* cpt = dcs + t * 16 + (d8 & 15);
          const float* spt = dsn + t * 16 + (d8 & 15);
          const float4 ca = *(const float4*)cpt, cb4 = *(const float4*)(cpt + 4);
          const float4 sa4 = *(const float4*)spt, sb4 = *(const float4*)(spt + 4);
          const float cs[8] = {ca.x, ca.y, ca.z, ca.w, cb4.x, cb4.y, cb4.z, cb4.w};
          const float sn[8] = {sa4.x, sa4.y, sa4.z, sa4.w, sb4.x, sb4.y, sb4.z, sb4.w};
#pragma unroll
          for (int e = 0; e < 8; ++e) {
            float kp = bf2f((bf16_t)kp8[e]), qp = bf2f((bf16_t)qp8[e]);
            if (d8 < 16) { kf[e] = kf[e] * cs[e] - kp * sn[e]; qf[e] = qf[e] * cs[e] - qp * sn[e]; }
            else { kf[e] = kf[e] * cs[e] + kp * sn[e]; qf[e] = qf[e] * cs[e] + qp * sn[e]; }
          }
        }
        uint4 ko, qo;
        ko.x = pack2(kf[0], kf[1]); ko.y = pack2(kf[2], kf[3]); ko.z = pack2(kf[4], kf[5]); ko.w = pack2(kf[6], kf[7]);
        qo.x = pack2(qf[0], qf[1]); qo.y = pack2(qf[2], qf[3]); qo.z = pack2(qf[4], qf[5]); qo.w = pack2(qf[6], qf[7]);
        *(uint4*)(KR + ((size_t)((seq * 4 + hh) * 2 + m) * NK + t) * 32 + d8) = ko;
        bf16_t* qg = QGZ + tok * 768 + c8;
        *(uint4*)(qg) = qo;
        *(uint4*)(qg + 256) = *(const uint4*)(F + tok * PIN + OB + 768 + c8);
        *(uint4*)(qg + 512) = *(const uint4*)(F + tok * PIN + OC + c8);
      }
    }
    {
      const float* cw = p.in[I_SCW] + (size_t)l * 3 * 512;
      const float* cb = p.in[I_SCB] + (size_t)l * 512;
      if (tid < 128) {
        const int qd = tid >> 6, cc8 = (tid & 63) * 8;
        const int tb = t0 + qd * 4;
        const bf16_t* fr = F + (size_t)(tok0 + qd * 4) * PIN + OC + 256 + cc8;
        bf16x8 rows[6];
#pragma unroll
        for (int r = 0; r < 6; ++r) {
          const int tr = tb + r - 1;
          bf16x8 z8 = {0, 0, 0, 0, 0, 0, 0, 0};
          rows[r] = z8;
          if (tr >= 0 && tr < T) rows[r] = *(const bf16x8*)(fr + (long)(r - 1) * PIN);
        }
        const float4 w0a = *(const float4*)(cw + cc8), w0b = *(const float4*)(cw + cc8 + 4);
        const float4 w1a = *(const float4*)(cw + 512 + cc8), w1b = *(const float4*)(cw + 512 + cc8 + 4);
        const float4 w2a = *(const float4*)(cw + 1024 + cc8), w2b = *(const float4*)(cw + 1024 + cc8 + 4);
        const float4 bba = *(const float4*)(cb + cc8), bbb = *(const float4*)(cb + cc8 + 4);
        const float w0[8] = {w0a.x, w0a.y, w0a.z, w0a.w, w0b.x, w0b.y, w0b.z, w0b.w};
        const float w1[8] = {w1a.x, w1a.y, w1a.z, w1a.w, w1b.x, w1b.y, w1b.z, w1b.w};
        const float w2[8] = {w2a.x, w2a.y, w2a.z, w2a.w, w2b.x, w2b.y, w2b.z, w2b.w};
        const float bb[8] = {bba.x, bba.y, bba.z, bba.w, bbb.x, bbb.y, bbb.z, bbb.w};
        const int dst = (cc8 < 256) ? 256 + cc8 : ((cc8 < 384) ? 128 + (cc8 - 256) : (cc8 - 384));
#pragma unroll
        for (int o4 = 0; o4 < 4; ++o4) {
          h16x8 o;
#pragma unroll
          for (int e = 0; e < 8; ++e) {
            float acc = bb[e] + w1[e] * bf2f((bf16_t)rows[o4 + 1][e]) + w0[e] * bf2f((bf16_t)rows[o4][e]) +
                        w2[e] * bf2f((bf16_t)rows[o4 + 2][e]);
            o[e] = (h16)silu_f(acc);
          }
          *(h16x8*)(FSSD + (size_t)(tok0 + qd * 4 + o4) * 512 + dst) = o;
        }
      }
      if (tid < 64) {
        int tl = tid >> 3, dh = tid & 7;
        size_t tok = (size_t)(tok0 + tl);
        float raw = bf2f(F[tok * PIN + OC + 768 + dh]) + p.in[I_DTB][l * 8 + dh];
        float dt = softplus_f(raw);
        float gm = fexp(-expf(p.in[I_ALOG][l * 8 + dh]) * dt);
        DTG[tok * 16 + dh * 2] = dt;
        DTG[tok * 16 + dh * 2 + 1] = gm;
      }
    }
    {
      const int hh = c >> 6, e = c & 63;
      unsigned short vv[8];
#pragma unroll
      for (int tl = 0; tl < 8; ++tl) vv[tl] = F[(size_t)(tok0 + tl) * PIN + OD + 512 + c];
      uint4 o;
      o.x = (unsigned)vv[0] | ((unsigned)vv[1] << 16);
      o.y = (unsigned)vv[2] | ((unsigned)vv[3] << 16);
      o.z = (unsigned)vv[4] | ((unsigned)vv[5] << 16);
      o.w = (unsigned)vv[6] | ((unsigned)vv[7] << 16);
      *(uint4*)(VT + ((size_t)(seq * 4 + hh) * 64 + e) * NK + t0) = o;
    }
    __syncthreads();
  }
}

template <int CTRL>
DI float dppx(float v) {
  return __builtin_bit_cast(float, __builtin_amdgcn_update_dpp(0, __builtin_bit_cast(int, v), CTRL, 0xf, 0xf, false));
}
template <int LPR>
DI float grp_sum(float v) {
  if (LPR == 16) {
    v += dppx<0x128>(v);
    v += dppx<0x124>(v);
    v += dppx<0x122>(v);
    v += dppx<0x121>(v);
  } else {
    v += dppx<0xB1>(v);
    v += dppx<0x4E>(v);
    v += dppx<0x141>(v);
  }
  return v;
}

template <int MIX, int KPL>
DI void scan_task(const Params& p, int sid, int l, int seq, int h, int dir, int q, float* lds) {
  constexpr int LPR = 64 / KPL;
  constexpr int R = (KPL == 8) ? 2 : 1;
  constexpr int RPW = (64 / LPR) * R;
  constexpr int RPB = 4 * RPW;
  constexpr int NV4 = KPL / 4;
  const int T = sid ? 4096 : 256;
  const int tid = tidx(), lane = tid & 63, wv = tid >> 6, j = lane % LPR, rw = lane / LPR;
  const int rowl = wv * RPW + rw * R;
  const int row = q * RPB + rowl;
  const size_t tokbase = (size_t)seq * T;
  const h16* feed;
  int ts, o0, o1, o2 = 0, o3 = 0, o4 = 0, ov;
  constexpr int NVEC = (MIX == 0) ? 5 : 2;
  if (MIX == 0) {
    feed = (const h16*)(p.ws + WS_FEED_RW);
    ts = 2304;
    o0 = 0 * 256 + h * 64;
    o1 = (4 + 3 * dir) * 256 + h * 64;
    o2 = 2 * 256 + h * 64;
    o3 = (3 + 3 * dir) * 256 + h * 64;
    o4 = (5 + 3 * dir) * 256 + h * 64;
    ov = 1 * 256 + h * 64 + q * RPB;
  } else if (MIX == 1) {
    feed = (const h16*)(p.ws + WS_FEED_RET);
    ts = 768;
    o0 = h * 64;
    o1 = 256 + h * 64;
    ov = 512 + h * 64 + q * RPB;
  } else {
    feed = (const h16*)(p.ws + WS_FEED_SSD);
    ts = 512;
    o0 = (h >> 1) * 64;
    o1 = 128 + (h >> 1) * 64;
    ov = 256 + h * 64 + q * RPB;
  }
  const float* DTG = (const float*)(p.ws + WS_DTG);
  float gconst = 1.f;
  if (MIX == 1) gconst = 1.f - exp2f(-(dir ? 5.5f : 5.0f) - (float)h);
  float S[R * KPL];
#pragma unroll
  for (int e = 0; e < R * KPL; ++e) S[e] = 0.f;
  if (sid) {
    size_t sb = ((size_t)((seq * 2 + l) * 2 + dir) * 4 + h) * 4096;
#pragma unroll
    for (int rr = 0; rr < R; ++rr) {
      if (MIX == 0) {
#pragma unroll
        for (int e4 = 0; e4 < NV4; ++e4) {
          float4 s4 = *(const float4*)(p.in[I_SRW] + sb + (row + rr) * 64 + KPL * j + 4 * e4);
          S[rr * KPL + 4 * e4 + 0] = s4.x; S[rr * KPL + 4 * e4 + 1] = s4.y;
          S[rr * KPL + 4 * e4 + 2] = s4.z; S[rr * KPL + 4 * e4 + 3] = s4.w;
        }
      } else {
        const float* sp = p.in[MIX == 1 ? I_SRET : I_SSSD] + sb + row + rr;
#pragma unroll
        for (int e = 0; e < KPL; ++e) S[rr * KPL + e] = sp[(KPL * j + e) * 64];
      }
    }
  }
  float* Y = (float*)(p.ws + WS_Y) + ((size_t)(MIX * 2 + dir) * NT + tokbase) * 256 + h * 64 + row;

  constexpr int NPV = RPB / 8;
  constexpr int NP = NVEC * 8 + NPV;
  constexpr int TOTAL = NP * TC;
  constexpr int NL = (TOTAL + 255) / 256;
  uint4 lr[2][NL];
  float2 lsc[2] = {make_float2(0.f, 0.f), make_float2(0.f, 0.f)};
  const h16* srcp[NL];
  int dsto[NL];
  bool lval[NL];
#pragma unroll
  for (int i = 0; i < NL; ++i) {
    int idx = tid + i * 256;
    lval[i] = idx < TOTAL;
    if (idx >= TOTAL) idx = TOTAL - 1;
    int s_ = idx / NP, pp = idx - s_ * NP;
    int off, dst;
    if (pp < NVEC * 8) {
      int vec = pp >> 3, part = pp & 7;
      off = (vec == 0 ? o0 : vec == 1 ? o1 : vec == 2 ? o2 : vec == 3 ? o3 : o4) + part * 8;
      dst = s_ * SST + vec * 64 + part * 8;
    } else {
      off = ov + (pp - NVEC * 8) * 8;
      dst = s_ * SST + 320 + (pp - NVEC * 8) * 8;
    }
    size_t tok = tokbase + (dir ? T - 1 - s_ : s_);
    srcp[i] = feed + tok * ts + off;
    dsto[i] = dst;
  }
  const long cstride = (long)(dir ? -TC : TC) * ts;
  const float* dtgp = DTG + (tokbase + (dir ? T - 1 - (tid & (TC - 1)) : (tid & (TC - 1)))) * 16 + (dir * 4 + h) * 2;
  const long dstride = (long)(dir ? -TC : TC) * 16;
#define SCAN_ISSUE(SET, CH)                                                                     \
  {                                                                                             \
    _Pragma("unroll") for (int i = 0; i < NL; ++i) {                                            \
      lr[SET][i] = *(const uint4*)(srcp[i] + (long)(CH) * cstride);                             \
    }                                                                                           \
    if (MIX == 2) lsc[SET] = *(const float2*)(dtgp + (long)(CH) * dstride);                     \
  }
#define SCAN_COMMIT(SET, BUF)                                                                   \
  {                                                                                             \
    float* Bw = lds + (BUF) * SBUF;                                                             \
    _Pragma("unroll") for (int i = 0; i < NL; ++i) {                                            \
      if (lval[i]) {                                                                            \
        h16x8 hv = __builtin_bit_cast(h16x8, lr[SET][i]);                                       \
        float4 a_, b_;                                                                          \
        a_.x = (float)hv[0]; a_.y = (float)hv[1]; a_.z = (float)hv[2]; a_.w = (float)hv[3];     \
        b_.x = (float)hv[4]; b_.y = (float)hv[5]; b_.z = (float)hv[6]; b_.w = (float)hv[7];     \
        *(float4*)(Bw + dsto[i]) = a_;                                                          \
        *(float4*)(Bw + dsto[i] + 4) = b_;                                                      \
      }                                                                                         \
    }                                                                                           \
    if (MIX == 2 && tid < TC) {                                                                 \
      Bw[tid * SST + 384] = lsc[SET].y;                                                         \
      Bw[tid * SST + 385] = lsc[SET].x;                                                         \
    }                                                                                           \
  }

  const int NCH = T / TC;
  SCAN_ISSUE(0, 0)
  SCAN_COMMIT(0, 0)
  SCAN_ISSUE(1, 1)
  __syncthreads();
  for (int ch2 = 0; ch2 < NCH; ch2 += 2) {
#pragma unroll
  for (int half = 0; half < 2; ++half) {
    const int ch = ch2 + half;
    const int buf = half;
    {
      const int chn = (ch + 2 < NCH) ? ch + 2 : NCH - 1;
      SCAN_ISSUE(half, chn)
    }
    const float* B = lds + buf * SBUF;
    float yp[R * TC];
    yp[0] = 0.f;
    if constexpr (KPL == 4) {
      const unsigned lb = (unsigned)(size_t)B;
      const unsigned a4 = lb + 16u * (unsigned)j;
      const unsigned a1 = lb + 4u * (unsigned)(320 + rowl);
      const unsigned a0 = lb + 4u * 384u;
      v2f_t Sa, Sb;
      Sa.x = S[0]; Sa.y = S[1]; Sb.x = S[2]; Sb.y = S[3];
      v4f_t QR[2][2], QK[2][2], QKK[2][2], QW[2][2], QB[2][2];
      float QV[2][2], QG[2][2], QDT[2][2];
#define DSR128(dst, base, OFF) asm volatile("ds_read_b128 %0, %1 offset:%2" : "=v"(dst) : "v"(base), "n"(OFF))
#define DSR32(dst, base, OFF) asm volatile("ds_read_b32 %0, %1 offset:%2" : "=v"(dst) : "v"(base), "n"(OFF))
#define LDS1(Z, U, S_)                                   \
  {                                                      \
    DSR128(QR[Z][U], a4, (S_) * SST * 4);                \
    DSR128(QK[Z][U], a4, (S_) * SST * 4 + 256);          \
    DSR32(QV[Z][U], a1, (S_) * SST * 4);                 \
    if (MIX == 0) {                                      \
      DSR128(QKK[Z][U], a4, (S_) * SST * 4 + 512);       \
      DSR128(QW[Z][U], a4, (S_) * SST * 4 + 768);        \
      DSR128(QB[Z][U], a4, (S_) * SST * 4 + 1024);       \
    }                                                    \
    if (MIX == 2) {                                      \
      DSR32(QG[Z][U], a0, (S_) * SST * 4);               \
      DSR32(QDT[Z][U], a0, (S_) * SST * 4 + 4);          \
    }                                                    \
  }
#define LDG(Z, G_) { LDS1(Z, 0, (G_) * 2 + 0) LDS1(Z, 1, (G_) * 2 + 1) }
#define WAITG(Z)                                                                                                     \
  {                                                                                                                  \
    if (MIX == 0) {                                                                                                  \
      asm volatile("s_waitcnt lgkmcnt(0)"                                                                            \
                   : "+v"(QR[Z][0]), "+v"(QR[Z][1]), "+v"(QK[Z][0]), "+v"(QK[Z][1]), "+v"(QKK[Z][0]),                \
                     "+v"(QKK[Z][1]), "+v"(QW[Z][0]), "+v"(QW[Z][1]), "+v"(QB[Z][0]), "+v"(QB[Z][1]),                \
                     "+v"(QV[Z][0]), "+v"(QV[Z][1])::"memory");                                                      \
    } else if (MIX == 1) {                                                                                           \
      asm volatile("s_waitcnt lgkmcnt(0)"                                                                            \
                   : "+v"(QR[Z][0]), "+v"(QR[Z][1]), "+v"(QK[Z][0]), "+v"(QK[Z][1]), "+v"(QV[Z][0]),                 \
                     "+v"(QV[Z][1])::"memory");                                                                      \
    } else {                                                                                                         \
      asm volatile("s_waitcnt lgkmcnt(0)"                                                                            \
                   : "+v"(QR[Z][0]), "+v"(QR[Z][1]), "+v"(QK[Z][0]), "+v"(QK[Z][1]), "+v"(QV[Z][0]), "+v"(QV[Z][1]), \
                     "+v"(QG[Z][0]), "+v"(QG[Z][1]), "+v"(QDT[Z][0]), "+v"(QDT[Z][1])::"memory");                    \
    }                                                                                                                \
  }
#define STEP4(Z, U, S_)                                                                             \
  {                                                                                                 \
    float vv = QV[Z][U];                                                                            \
    if (MIX == 0) {                                                                                 \
      v2f_t t2 = Sa * QKK[Z][U].xy + Sb * QKK[Z][U].zw;                                             \
      float sa = -grp_sum<16>(t2.x + t2.y);                                                         \
      Sa = (Sa * QW[Z][U].xy + vv * QK[Z][U].xy) + sa * QB[Z][U].xy;                                \
      Sb = (Sb * QW[Z][U].zw + vv * QK[Z][U].zw) + sa * QB[Z][U].zw;                                \
    } else {                                                                                        \
      float g = gconst;                                                                             \
      if (MIX == 2) { g = QG[Z][U]; vv *= QDT[Z][U]; }                                              \
      Sa = g * Sa + vv * QK[Z][U].xy;                                                               \
      Sb = g * Sb + vv * QK[Z][U].zw;                                                               \
    }                                                                                               \
    v2f_t y2 = Sa * QR[Z][U].xy + Sb * QR[Z][U].zw;                                                 \
    yp[S_] = y2.x + y2.y;                                                                           \
  }
#define GROUP4(Z, G_) { STEP4(Z, 0, (G_) * 2 + 0) STEP4(Z, 1, (G_) * 2 + 1) }
      LDG(0, 0)
      WAITG(0) LDG(1, 1) GROUP4(0, 0)
      WAITG(1) LDG(0, 2) GROUP4(1, 1)
      WAITG(0) LDG(1, 3) GROUP4(0, 2)
      WAITG(1) LDG(0, 4) GROUP4(1, 3)
      WAITG(0) LDG(1, 5) GROUP4(0, 4)
      WAITG(1) LDG(0, 6) GROUP4(1, 5)
      WAITG(0) LDG(1, 7) GROUP4(0, 6)
      WAITG(1) GROUP4(1, 7)
      S[0] = Sa.x; S[1] = Sa.y; S[2] = Sb.x; S[3] = Sb.y;
#undef DSR128
#undef DSR32
#undef LDS1
#undef LDG
#undef WAITG
#undef STEP4
#undef GROUP4
    } else {
    v2f_t Sv[R][4];
#pragma unroll
    for (int rr = 0; rr < R; ++rr)
#pragma unroll
      for (int e = 0; e < 4; ++e) { Sv[rr][e].x = S[rr * KPL + 2 * e]; Sv[rr][e].y = S[rr * KPL + 2 * e + 1]; }
    v4f_t nr[2], nk[2], nkk[2], nw[2], nb[2];
    float nvv[R], ng = 0.f, ndt = 0.f;
#pragma unroll
    for (int e = 0; e < 2; ++e) { nkk[e] = (v4f_t)(0.f); nw[e] = (v4f_t)(0.f); nb[e] = (v4f_t)(0.f); }
#define LD_VEC(dst, off_)                                                         \
  _Pragma("unroll") for (int e4 = 0; e4 < 2; ++e4) dst[e4] = *(const v4f_t*)(L + (off_) + KPL * j + 4 * e4);
#define LD_STEP(S_)                                  \
  {                                                  \
    const float* L = B + (S_) * SST;                 \
    LD_VEC(nr, 0)                                    \
    LD_VEC(nk, 64)                                   \
    _Pragma("unroll") for (int rr = 0; rr < R; ++rr) nvv[rr] = L[320 + rowl + rr]; \
    if (MIX == 0) {                                  \
      LD_VEC(nkk, 128)                               \
      LD_VEC(nw, 192)                                \
      LD_VEC(nb, 256)                                \
    }                                                \
    if (MIX == 2) {                                  \
      ng = L[384];                                   \
      ndt = L[385];                                  \
    }                                                \
  }
    LD_STEP(0)
#pragma unroll
    for (int s = 0; s < TC; ++s) {
      v4f_t r_[2], k_[2], kk_[2], w_[2], b_[2];
#pragma unroll
      for (int e = 0; e < 2; ++e) { r_[e] = nr[e]; k_[e] = nk[e]; kk_[e] = nkk[e]; w_[e] = nw[e]; b_[e] = nb[e]; }
      float vvr[R], g = ng, dtv = ndt;
#pragma unroll
      for (int rr = 0; rr < R; ++rr) vvr[rr] = nvv[rr];
      if (s + 1 < TC) LD_STEP(s + 1)
#pragma unroll
      for (int rr = 0; rr < R; ++rr) {
        float vv = vvr[rr];
        if (MIX == 0) {
          v2f_t ta = Sv[rr][0] * kk_[0].xy + Sv[rr][1] * kk_[0].zw;
          v2f_t tb = Sv[rr][2] * kk_[1].xy + Sv[rr][3] * kk_[1].zw;
          v2f_t t2 = ta + tb;
          float sa = -grp_sum<LPR>(t2.x + t2.y);
          Sv[rr][0] = (Sv[rr][0] * w_[0].xy + vv * k_[0].xy) + sa * b_[0].xy;
          Sv[rr][1] = (Sv[rr][1] * w_[0].zw + vv * k_[0].zw) + sa * b_[0].zw;
          Sv[rr][2] = (Sv[rr][2] * w_[1].xy + vv * k_[1].xy) + sa * b_[1].xy;
          Sv[rr][3] = (Sv[rr][3] * w_[1].zw + vv * k_[1].zw) + sa * b_[1].zw;
        } else {
          float gg = (MIX == 1) ? gconst : g;
          if (MIX == 2) vv *= dtv;
          Sv[rr][0] = gg * Sv[rr][0] + vv * k_[0].xy;
          Sv[rr][1] = gg * Sv[rr][1] + vv * k_[0].zw;
          Sv[rr][2] = gg * Sv[rr][2] + vv * k_[1].xy;
          Sv[rr][3] = gg * Sv[rr][3] + vv * k_[1].zw;
        }
        v2f_t ya = Sv[rr][0] * r_[0].xy + Sv[rr][1] * r_[0].zw;
        v2f_t yb = Sv[rr][2] * r_[1].xy + Sv[rr][3] * r_[1].zw;
        v2f_t y2 = ya + yb;
        yp[rr * TC + s] = y2.x + y2.y;
      }
    }
#pragma unroll
    for (int rr = 0; rr < R; ++rr)
#pragma unroll
      for (int e = 0; e < 4; ++e) { S[rr * KPL + 2 * e] = Sv[rr][e].x; S[rr * KPL + 2 * e + 1] = Sv[rr][e].y; }
    }
#undef LD_STEP
#undef LD_VEC
#define BFLY(YP_, N_, BIT_, CTRL_)                                    \
  _Pragma("unroll") for (int i = 0; i < (N_) / 2; ++i) {              \
    float lo = (YP_)[i], hi = (YP_)[i + (N_) / 2];                    \
    float keep = (BIT_) ? hi : lo, send = (BIT_) ? lo : hi;           \
    (YP_)[i] = keep + dppx<CTRL_>(send);                              \
  }
    if (LPR == 16) {
      BFLY(yp, 16, (j & 8), 0x140)
      BFLY(yp, 8, (j & 4), 0x141)
      BFLY(yp, 4, (j & 2), 0x1B)
      BFLY(yp, 2, (j & 1), 0xB1)
      int sg = ch * TC + j;
      int t = dir ? T - 1 - sg : sg;
      Y[(size_t)t * 256] = yp[0];
    } else {
#pragma unroll
      for (int rr = 0; rr < R; ++rr) {
        float* ypr = yp + rr * TC;
        BFLY(ypr, 16, (j & 4), 0x141)
        BFLY(ypr, 8, (j & 2), 0x1B)
        BFLY(ypr, 4, (j & 1), 0xB1)
        int sg = ch * TC + 2 * j;
        int t0_ = dir ? T - 1 - sg : sg;
        int t1_ = dir ? t0_ - 1 : t0_ + 1;
        Y[(size_t)t0_ * 256 + rr] = ypr[0];
        Y[(size_t)t1_ * 256 + rr] = ypr[1];
      }
    }
#undef BFLY
    if (ch + 1 < NCH) SCAN_COMMIT(half ^ 1, half ^ 1)
    lds_barrier();
  }
  }
#undef SCAN_ISSUE
#undef SCAN_COMMIT
  if (sid == 0) {
    size_t sb = ((size_t)((seq * 2 + l) * 2 + dir) * 4 + h) * 4096;
#pragma unroll
    for (int rr = 0; rr < R; ++rr) {
      if (MIX == 0) {
#pragma unroll
        for (int e4 = 0; e4 < NV4; ++e4)
          *(float4*)(p.out + O_SRW + sb + (row + rr) * 64 + KPL * j + 4 * e4) =
              make_float4(S[rr * KPL + 4 * e4 + 0], S[rr * KPL + 4 * e4 + 1], S[rr * KPL + 4 * e4 + 2], S[rr * KPL + 4 * e4 + 3]);
      } else {
        float* sp = p.out + (MIX == 1 ? O_SRET : O_SSSD) + sb + row + rr;
#pragma unroll
        for (int e = 0; e < KPL; ++e) sp[(KPL * j + e) * 64] = S[rr * KPL + e];
      }
    }
  }
}

DI void attn_task(const Params& p, int sid, int l, int seq, int h, int qb) {
  const int T = sid ? 4096 : 256;
  const int NK = sid ? 4608 : 256;
  const int lane = tidx() & 63, wv = tidx() >> 6;
  const int r = lane & 31, hf = lane >> 5;
  const int tq = qb * 128 + wv * 32 + r;
  const size_t tok = (size_t)seq * T + tq;
  const bf16_t* F = wsbf(p, WS_F);
  float lam_init = 0.8f - 0.6f * expf(-0.3f * (float)l);
  float lam;
  {
    const float* lp = opaque(p.in[I_DLAM] + l * 128);
    float s01 = wave_sum(lp[lane & 31] * lp[32 + (lane & 31)]) * 0.5f;
    float s23 = wave_sum(lp[64 + (lane & 31)] * lp[96 + (lane & 31)]) * 0.5f;
    lam = expf(s01) - expf(s23) + lam_init;
    asm volatile("" : "+v"(lam));
  }
  bf16x8 qf[2][2];
  {
    const bf16_t* fq = wsbf(p, WS_QGZ) + tok * 768 + h * 64;
#pragma unroll
    for (int m = 0; m < 2; ++m) {
      qf[m][0] = *(const bf16x8*)(fq + m * 32 + 8 * hf);
      qf[m][1] = *(const bf16x8*)(fq + m * 32 + 16 + 8 * hf);
    }
  }
  const bf16_t* Kb = wsbf(p, WS_KR) + (size_t)(seq * 4 + h) * 2 * NK * 32;
  const bf16_t* Vb = wsbf(p, WS_VT) + (size_t)(seq * 4 + h) * 64 * NK;
  f32x16 O[2][2];
#pragma unroll
  for (int a = 0; a < 2; ++a)
#pragma unroll
    for (int b = 0; b < 2; ++b)
#pragma unroll
      for (int i = 0; i < 16; ++i) O[a][b][i] = 0.f;
  float mx[2] = {-1e30f, -1e30f}, ls[2] = {0.f, 0.f};
  const float sc = 0.17677669529663687f * 1.4426950408889634f;
  const int NKT = NK / 32;
#pragma unroll 1
  for (int kt = 0; kt < NKT; ++kt) {
    bf16x8 vf[2][2];
#pragma unroll
    for (int mt = 0; mt < 2; ++mt)
#pragma unroll
      for (int s = 0; s < 2; ++s) {
        const bf16_t* vp = Vb + (size_t)(mt * 32 + r) * NK + kt * 32 + 16 * s + 4 * hf;
        uint2 lo = *(const uint2*)vp;
        uint2 hi = *(const uint2*)(vp + 8);
        uint4 cmb = make_uint4(lo.x, lo.y, hi.x, hi.y);
        vf[mt][s] = __builtin_bit_cast(bf16x8, cmb);
      }
#pragma unroll
    for (int m = 0; m < 2; ++m) {
      f32x16 S;
#pragma unroll
      for (int i = 0; i < 16; ++i) S[i] = 0.f;
#pragma unroll
      for (int s = 0; s < 2; ++s) {
        bf16x8 kf = *(const bf16x8*)(Kb + ((size_t)m * NK + kt * 32 + r) * 32 + 16 * s + 8 * hf);
        S = MFMA32(kf, qf[m][s], S);
      }
      float tmax = S[0];
#pragma unroll
      for (int i = 1; i < 16; ++i) tmax = fmaxf(tmax, S[i]);
      tmax = fmaxf(tmax, __shfl_xor(tmax, 32));
      float mnew = fmaxf(mx[m], tmax * sc);
      float alpha = exp2f(mx[m] - mnew);
      mx[m] = mnew;
      float psum = 0.f;
#pragma unroll
      for (int i = 0; i < 16; ++i) {
        S[i] = exp2f(S[i] * sc - mnew);
        psum += S[i];
      }
      ls[m] = ls[m] * alpha + psum;
#pragma unroll
      for (int mt = 0; mt < 2; ++mt)
#pragma unroll
        for (int i = 0; i < 16; ++i) O[m][mt][i] *= alpha;
#pragma unroll
      for (int s = 0; s < 2; ++s) {
        uint4 pk;
        pk.x = pack2(S[8 * s + 0], S[8 * s + 1]);
        pk.y = pack2(S[8 * s + 2], S[8 * s + 3]);
        pk.z = pack2(S[8 * s + 4], S[8 * s + 5]);
        pk.w = pack2(S[8 * s + 6], S[8 * s + 7]);
        bf16x8 pf = __builtin_bit_cast(bf16x8, pk);
        O[m][0] = MFMA32(vf[0][s], pf, O[m][0]);
        O[m][1] = MFMA32(vf[1][s], pf, O[m][1]);
      }
    }
  }
  ls[0] += __shfl_xor(ls[0], 32);
  ls[1] += __shfl_xor(ls[1], 32);
  const float inv0 = 1.f / ls[0], inv1 = lam / ls[1];
  float ss = 0.f;
#pragma unroll
  for (int mt = 0; mt < 2; ++mt)
#pragma unroll
    for (int i = 0; i < 16; ++i) {
      float o = O[0][mt][i] * inv0 - O[1][mt][i] * inv1;
      O[0][mt][i] = o;
      ss += o * o;
    }
  ss += __shfl_xor(ss, 32);
  const float rstd = rsqrtf(ss * (1.f / 64.f) + 1e-6f) * (1.f - lam_init);
  const float* sg = opaque(p.in[I_DSUB] + l * 64);
  bf16_t* cat = (bf16_t*)(p.ws + WS_CAT) + tok * D + 768 + h * 64;
#pragma unroll
  for (int mt = 0; mt < 2; ++mt)
#pragma unroll
    for (int g4 = 0; g4 < 4; ++g4) {
      int e0 = mt * 32 + 8 * g4 + 4 * hf;
      uint2 o;
      o.x = pack2(O[0][mt][4 * g4 + 0] * rstd * sg[e0 + 0], O[0][mt][4 * g4 + 1] * rstd * sg[e0 + 1]);
      o.y = pack2(O[0][mt][4 * g4 + 2] * rstd * sg[e0 + 2], O[0][mt][4 * g4 + 3] * rstd * sg[e0 + 3]);
      *(uint2*)(cat + e0) = o;
    }
}

DI void stage_mix(const Params& p, int sid, int l, char* smem) {
  const int NSEQ = sid ? 2 : 32;
  const int T = sid ? 4096 : 256;
  const int NQ = sid ? 4 : 1;
  const int nscan1 = NSEQ * 4 * 2 * NQ;
  const int nattn = NSEQ * 4 * (T / 128);
#define SCAN_LOOP(MIXI, BASE)                                                                 \
  for (int task = first_task(BASE); task < (BASE) + nscan1; task += gridDim.x) {             \
    int u = task - (BASE);                                                                    \
    int q = u % NQ, v_ = u / NQ;                                                              \
    int dir = v_ & 1, h = (v_ >> 1) & 3, seq = v_ >> 3;                                       \
    if (sid) scan_task<MIXI, 4>(p, sid, l, seq, h, dir, q, (float*)smem);                     \
    else scan_task<MIXI, 8>(p, sid, l, seq, h, dir, q, (float*)smem);                         \
  }
  SCAN_LOOP(0, 0)
  SCAN_LOOP(1, nscan1)
  SCAN_LOOP(2, 2 * nscan1)
#undef SCAN_LOOP
  for (int task = first_task(3 * nscan1); task < 3 * nscan1 + nattn; task += gridDim.x) {
    int u = task - 3 * nscan1;
    int nqb = T / 128;
    int qb = u % nqb, h = (u / nqb) & 3, seq = u / (nqb * 4);
    attn_task(p, sid, l, seq, h, qb);
  }
  if (sid) {
    const int nlong = 3 * nscan1;
    if ((int)gridDim.x > nlong + 64) {
      if ((int)blockIdx.x >= nlong) stage_g1(p, 0, l, smem, (int)blockIdx.x - nlong, (int)gridDim.x - nlong);
    } else {
      stage_g1(p, 0, l, smem, (int)blockIdx.x, (int)gridDim.x);
    }
  }
}

DI float4 ld_h4(const h16* q) {
  uint2 u = *(const uint2*)q;
  typedef _Float16 h4 __attribute__((ext_vector_type(4)));
  h4 v = __builtin_bit_cast(h4, u);
  return make_float4((float)v[0], (float)v[1], (float)v[2], (float)v[3]);
}
DI float4 ld_bf4(const bf16_t* q) {
  uint2 u = *(const uint2*)q;
  return make_float4(__uint_as_float(u.x << 16), __uint_as_float(u.x & 0xffff0000u), __uint_as_float(u.y << 16),
                     __uint_as_float(u.y & 0xffff0000u));
}
DI void st_bf4(bf16_t* q, float a, float b, float c, float d) {
  uint2 o;
  o.x = pack2(a, b);
  o.y = pack2(c, d);
  *(uint2*)q = o;
}
DI float4 f4add(float4 a, float4 b) { return make_float4(a.x + b.x, a.y + b.y, a.z + b.z, a.w + b.w); }

DI void stage_post(const Params& p, int sid, int l, char* smem) {
  const int tid = tidx(), wv = tid >> 6, lane = tid & 63;
  const int c0 = lane * 4, head = lane >> 4;
  const float* Y = (const float*)(p.ws + WS_Y);
  const bf16_t* QGZ = wsbf(p, WS_QGZ);
  const h16* RG = (const h16*)(p.ws + WS_RG);
  const h16* BON = (const h16*)(p.ws + WS_BONUS);
  const h16* FSSD = (const h16*)(p.ws + WS_FEED_SSD);
  bf16_t* cat = (bf16_t*)(p.ws + WS_CAT);
  const float4 lng = *(const float4*)(p.in[I_LNG] + l * 256 + c0), lnb = *(const float4*)(p.in[I_LNB] + l * 256 + c0);
  const float4 retg = *(const float4*)(p.in[I_RETG] + l * 256 + c0);
  const float4 sng = *(const float4*)(p.in[I_SNG] + l * 256 + c0);
  const float sd = p.in[I_SD][l * 4 + head];
  const size_t YS = (size_t)NT * 256;
#pragma unroll 2
  for (int tok = blockIdx.x * 4 + wv; tok < NT; tok += gridDim.x * 4) {
    const size_t tb = (size_t)tok * 256 + c0;
    {
      float4 y = f4add(*(const float4*)(Y + tb), *(const float4*)(Y + YS + tb));
      float mu = row_sum16((y.x + y.y) + (y.z + y.w)) * (1.f / 64.f);
      float d0 = y.x - mu, d1 = y.y - mu, d2 = y.z - mu, d3 = y.w - mu;
      float var = row_sum16((d0 * d0 + d1 * d1) + (d2 * d2 + d3 * d3)) * (1.f / 64.f);
      float rs = rsqrtf(var + 64e-5f);
      float4 bo = ld_h4(BON + tb), g = ld_h4(RG + tb);
      st_bf4(cat + (size_t)tok * D + c0, (d0 * rs * lng.x + lnb.x + bo.x) * g.x, (d1 * rs * lng.y + lnb.y + bo.y) * g.y,
             (d2 * rs * lng.z + lnb.z + bo.z) * g.z, (d3 * rs * lng.w + lnb.w + bo.w) * g.w);
    }
    {
      float4 y = f4add(*(const float4*)(Y + 2 * YS + tb), *(const float4*)(Y + 3 * YS + tb));
      float ms = row_sum16((y.x * y.x + y.y * y.y) + (y.z * y.z + y.w * y.w)) * (1.f / 64.f);
      float rs = rsqrtf(ms + 1e-6f);
      float4 g = ld_bf4(QGZ + (size_t)tok * 768 + 256 + c0);
      st_bf4(cat + (size_t)tok * D + 256 + c0, silu_f(g.x) * y.x * rs * retg.x, silu_f(g.y) * y.y * rs * retg.y,
             silu_f(g.z) * y.z * rs * retg.z, silu_f(g.w) * y.w * rs * retg.w);
    }
    {
      float4 y = f4add(*(const float4*)(Y + 4 * YS + tb), *(const float4*)(Y + 5 * YS + tb));
      float4 x = ld_h4(FSSD + (size_t)tok * 512 + 256 + c0);
      float4 z = ld_bf4(QGZ + (size_t)tok * 768 + 512 + c0);
      float y0 = (y.x + x.x * sd) * silu_f(z.x), y1 = (y.y + x.y * sd) * silu_f(z.y);
      float y2 = (y.z + x.z * sd) * silu_f(z.z), y3 = (y.w + x.w * sd) * silu_f(z.w);
      float ms = wave_sum((y0 * y0 + y1 * y1) + (y2 * y2 + y3 * y3)) * (1.f / 256.f);
      float rs = rsqrtf(ms + 1e-6f);
      st_bf4(cat + (size_t)tok * D + 512 + c0, y0 * rs * sng.x, y1 * rs * sng.y, y2 * rs * sng.z, y3 * rs * sng.w);
    }
  }
}

#define XB_TMO      128
#define XB_XCNT(j)  (256  + 64 * (j))
#define XB_XSUB(j)  (1280 + 64 * (j))
#define XB_XGEN(j)  (2304 + 64 * (j))
#define XB_TOP      3328
#define XB_TOPGEN   3392
#define XCD_BAR_WORDS 3456
#define XB_SPIN_CAP (1u << 22)
#define LAS __attribute__((address_space(3)))
DI unsigned xb_ld(unsigned* p) { return __hip_atomic_load(p, __ATOMIC_RELAXED, __HIP_MEMORY_SCOPE_AGENT); }
DI unsigned xb_add(unsigned* p, unsigned v) { return __hip_atomic_fetch_add(p, v, __ATOMIC_RELAXED, __HIP_MEMORY_SCOPE_AGENT); }
DI unsigned xb_xcc_id() { return (unsigned)__builtin_amdgcn_s_getreg((3 << 11) | 20) & 0xFu; }
#define XB_SPIN(cond, bar) do { unsigned _sp = 0; while (cond) { __builtin_amdgcn_s_sleep(1); \
    if ((++_sp & 255u) == 0u) { if (xb_ld(&(bar)[XB_TMO])) break; if (_sp > XB_SPIN_CAP) { atomicAdd(&(bar)[XB_TMO], 1u); break; } } } } while (0)
struct XcdBarrier { unsigned* bar; unsigned x; volatile LAS unsigned* st; };
DI XcdBarrier xcd_barrier_post(unsigned* bar, volatile LAS unsigned* st) {
  XcdBarrier b; b.bar = bar; b.x = xb_xcc_id(); b.st = st;
  if (threadIdx.x == 0) (void)xb_add(&bar[XB_XCNT(b.x)], 1u);
  return b;
}
DI void xcd_barrier_complete(unsigned* bar, unsigned x, unsigned& nloc, unsigned& nx) {
  const unsigned G = gridDim.x * gridDim.y * gridDim.z;
  unsigned sum, cnt, mine, sp = 0u;
  for (;;) {
    sum = 0u; cnt = 0u; mine = 0u;
#pragma unroll
    for (unsigned j = 0; j < 16; ++j) { const unsigned c = xb_ld(&bar[XB_XCNT(j)]); sum += c; cnt += (c > 0u) ? 1u : 0u; mine = (j == x) ? c : mine; }
    if (sum == G) break;
    __builtin_amdgcn_s_sleep(1);
    if ((++sp & 255u) == 0u) { if (xb_ld(&bar[XB_TMO])) break; if (sp > XB_SPIN_CAP) { atomicAdd(&bar[XB_TMO], 1u); break; } }
  }
  nloc = mine > 0u ? mine : 1u; nx = cnt > 0u ? cnt : 1u;
}
DI void xcd_barrier(const XcdBarrier& b) {
  asm volatile("s_waitcnt vmcnt(0)" ::: "memory");
  __syncthreads();
  if (threadIdx.x == 0) {
    unsigned* bar = b.bar;
    __builtin_amdgcn_s_waitcnt(0);
    unsigned nloc = b.st[0], nx = b.st[1];
    if (nloc == 0u) { xcd_barrier_complete(bar, b.x, nloc, nx); b.st[0] = nloc; b.st[1] = nx; }
    const unsigned old = xb_add(&bar[XB_XSUB(b.x)], 1u);
    const unsigned gen = old / nloc;
    if (old + 1u == (gen + 1u) * nloc) {
      __builtin_amdgcn_fence(__ATOMIC_RELEASE, "agent");
      asm volatile("s_waitcnt vmcnt(0)" ::: "memory");
      const unsigned og = xb_add(&bar[XB_TOP], 1u);
      const unsigned tg = og / nx;
      if (og + 1u == (tg + 1u) * nx) xb_add(&bar[XB_TOPGEN], 1u);
      else XB_SPIN(xb_ld(&bar[XB_TOPGEN]) == tg, bar);
      __builtin_amdgcn_fence(__ATOMIC_ACQUIRE, "agent");
      xb_add(&bar[XB_XGEN(b.x)], 1u);
      asm volatile("s_waitcnt vmcnt(0)" ::: "memory");
    } else {
      XB_SPIN(xb_ld(&bar[XB_XGEN(b.x)]) == gen, bar);
      __builtin_amdgcn_fence(__ATOMIC_ACQUIRE, "agent");
      asm volatile("s_waitcnt vmcnt(0)" ::: "memory");
    }
  }
  __syncthreads();
}

DI void run_phase(const Params& p, int ph, char* smem) {
  if (ph == 0) {
    stage0(p, smem);
    if ((int)gridDim.x >= 384) {
      if ((int)blockIdx.x >= 192) stage_w(p, 0, smem, (int)blockIdx.x - 192, (int)gridDim.x - 192);
    } else {
      stage_w(p, 0, smem, (int)blockIdx.x, (int)gridDim.x);
    }
    return;
  }
  if (ph == NPHASE - 1) { stage_final(p); return; }
  int qq = ph - 1;
  int l = qq / 18, k = qq % 18;
  switch (k) {
    case 0:
      if (l > 0) stage_w(p, l, smem, (int)blockIdx.x, (int)gridDim.x);
      stage_norm(p, 1, l, 0);
      break;
    case 1: stage_g1(p, 1, l, smem, (int)blockIdx.x, (int)gridDim.x); break;
    case 2:
      stage_prep(p, 1, l, smem);
      stage_norm(p, 0, l, 0);
      break;
    case 3: stage_mix(p, 1, l, smem); break;
    case 4: stage_post(p, 1, l, smem); break;
    case 5: stage_g2(p, 1, l, smem); break;
    case 6: stage_norm(p, 1, l, 1); break;
    case 7: stage_g3(p, smem); break;
    case 8: stage_conv(p, 1, l); break;
    case 9: stage_g4(p, 1, l, smem); break;
    case 10: stage_prep(p, 0, l, smem); break;
    case 11: stage_mix(p, 0, l, smem); break;
    case 12: stage_post(p, 0, l, smem); break;
    case 13: stage_g2(p, 0, l, smem); break;
    case 14: stage_norm(p, 0, l, 1); break;
    case 15: stage_g3(p, smem); break;
    case 16: stage_conv(p, 0, l); break;
    case 17: stage_g4(p, 0, l, smem); break;
  }
}

#if COOP
__global__ void __launch_bounds__(256, 2) mega_kernel(Params p) {
  __shared__ __attribute__((aligned(16))) char smem[SMEM_BYTES];
  __shared__ uint4 xb_words;
  if (threadIdx.x == 0) xb_words = make_uint4(0u, 0u, 0u, 0u);
  __syncthreads();
  XcdBarrier xb = xcd_barrier_post((unsigned*)(p.ws + WS_BAR), (volatile LAS unsigned*)&xb_words);
  if (p.ws == nullptr) cg::this_grid().sync();
  for (int ph = 0; ph < NPHASE; ++ph) {
    run_phase(p, ph, smem);
    if (ph + 1 < NPHASE) xcd_barrier(xb);
  }
}
#else
__global__ void __launch_bounds__(256, 2) phase_kernel(Params p, int ph) {
  __shared__ __attribute__((aligned(16))) char smem[SMEM_BYTES];
  run_phase(p, ph, smem);
}
#endif

extern "C" void kernel_launch(void* const* d_in, const int* in_sizes, int n_in, void* d_out, int out_size, void* d_ws,
                              size_t ws_size, hipStream_t stream) {
  Params p{};
  for (int i = 0; i < 40; ++i) p.in[i] = (const float*)d_in[i];
  p.out = (float*)d_out;
  p.ws = (char*)d_ws;
  static int grid_blocks = 0;
  if (!grid_blocks) {
    int dev = 0, cus = 0, per_cu = 0;
    hipGetDevice(&dev);
    hipDeviceGetAttribute(&cus, hipDeviceAttributeMultiprocessorCount, dev);
#if COOP
    hipOccupancyMaxActiveBlocksPerMultiprocessor(&per_cu, mega_kernel, 256, 0);
#else
    hipOccupancyMaxActiveBlocksPerMultiprocessor(&per_cu, phase_kernel, 256, 0);
#endif
    if (per_cu < 1) per_cu = 1;
    if (per_cu > 3) per_cu = 3;
    if (cus < 1) cus = 256;
    grid_blocks = cus * per_cu;
  }
#if COOP
  hipMemsetAsync((char*)d_ws + WS_BAR, 0, 16384, stream);
  void* args[] = {&p};
  hipError_t e = hipLaunchCooperativeKernel((void*)mega_kernel, dim3(grid_blocks), dim3(256), args, 0, stream);
  if (e != hipSuccess) fprintf(stderr, "cooperative launch failed: %s (grid %d)\n", hipGetErrorString(e), grid_blocks);
#else
  for (int ph = 0; ph < NPHASE; ++ph) phase_kernel<<<grid_blocks, 256, 0, stream>>>(p, ph);
#endif
}
```
